# Optimizing an MI355X kernel written in HIP

```python
import math
import jax, jax.numpy as jnp
from jax import lax
import numpy as np

D_MODEL = 1024
BATCH = 2
SEQ = 16384
DEPTH = 2
DEC_BATCH = 32
DEC_SEQ = 16
PAST_LEN = 4096

CHUNK = 64
MIX_W = D_MODEL
ATT_HEADS = 8
ATT_KV_HEADS = 2
ATT_GROUP = ATT_HEADS // ATT_KV_HEADS
ATT_HEAD_DIM = 64
ATT_Q_W = ATT_HEADS * ATT_HEAD_DIM
ATT_KV_W = ATT_KV_HEADS * ATT_HEAD_DIM
ATT_SCALE = ATT_HEAD_DIM ** -0.5
WINDOW = 128
BAND_CHUNKS = -(-WINDOW // CHUNK)
BAND = (BAND_CHUNKS + 1) * CHUNK
REL_BUCKETS = 32
REL_MAX_DIST = 128
RET_HEADS = 4
RET_KEY_DIM = 128
RET_VAL_DIM = 128
RET_QK_W = RET_HEADS * RET_KEY_DIM
RET_V_W = RET_HEADS * RET_VAL_DIM
ROPE_BASE = 10000.0
IN_SIZES = (ATT_Q_W, ATT_KV_W, ATT_KV_W, RET_QK_W, RET_QK_W, RET_V_W, RET_V_W)
IN_W = sum(IN_SIZES)
D_FF = 4 * D_MODEL
N_MOD = 6
EPS = 1e-6

kernel_name = 'hymba_swa_sink_retention_stream_step'


def rms_norm(x, g):
    xf = x.astype(jnp.float32)
    y = xf * lax.rsqrt(jnp.mean(xf * xf, axis=-1, keepdims=True) + EPS)
    return (y * g.astype(jnp.float32)).astype(x.dtype)


def modulate(x, g, shift, scale):
    return rms_norm(x, g) * (1.0 + scale[:, None, :]) + shift[:, None, :]


def ada_params(c, w, b):
    m = jnp.einsum('bd,de->be', jax.nn.silu(c), w) + b
    return jnp.split(m, N_MOD, axis=-1)


def rotary(x, pos):
    half = x.shape[-1] // 2
    inv = 1.0 / (ROPE_BASE ** (jnp.arange(half, dtype=jnp.float32) / half))
    ang = pos.astype(jnp.float32)[:, None] * inv[None, :]
    cos = jnp.cos(ang)[:, None, :]
    sin = jnp.sin(ang)[:, None, :]
    xf = x.astype(jnp.float32)
    x1, x2 = xf[..., :half], xf[..., half:]
    return jnp.concatenate([x1 * cos - x2 * sin, x2 * cos + x1 * sin], axis=-1).astype(x.dtype)


def rel_bucket(rel):
    nb = REL_BUCKETS // 2
    n = -rel
    ret = jnp.where(n < 0, nb, 0)
    n = jnp.abs(n)
    max_exact = nb // 2
    nf = jnp.maximum(n, 1).astype(jnp.float32)
    large = max_exact + (jnp.log(nf / max_exact) / math.log(REL_MAX_DIST / max_exact)
                         * (nb - max_exact)).astype(jnp.int32)
    large = jnp.minimum(large, nb - 1)
    return ret + jnp.where(n < max_exact, n, large)


def relative_bias(rel, table):
    b = table.astype(jnp.float32)[rel_bucket(rel)]
    q, j = rel.shape
    return jnp.transpose(b, (2, 0, 1)).reshape(ATT_KV_HEADS, ATT_GROUP, q, j)


def sink_softmax(s, sinks):
    sink = sinks.astype(jnp.float32).reshape(ATT_KV_HEADS, ATT_GROUP, 1, 1)
    m = jnp.maximum(jnp.max(s, axis=-1, keepdims=True), sink)
    e = jnp.exp(s - m)
    return e / (jnp.sum(e, axis=-1, keepdims=True) + jnp.exp(sink - m))


def project(h, w_in, pos):
    bsz, seq = h.shape[:2]
    u = jnp.einsum('bsd,de->bse', h, w_in)
    cuts = [sum(IN_SIZES[:i + 1]) for i in range(len(IN_SIZES) - 1)]
    qa, ka, va, qr, kr, vr, gr = jnp.split(u, cuts, axis=-1)
    qa = qa.reshape(bsz, seq, ATT_HEADS, ATT_HEAD_DIM)
    ka = ka.reshape(bsz, seq, ATT_KV_HEADS, ATT_HEAD_DIM)
    va = va.reshape(bsz, seq, ATT_KV_HEADS, ATT_HEAD_DIM)
    qr = rotary(qr.reshape(bsz, seq, RET_HEADS, RET_KEY_DIM), pos)
    kr = rotary(kr.reshape(bsz, seq, RET_HEADS, RET_KEY_DIM), pos) * (RET_KEY_DIM ** -0.5)
    vr = vr.reshape(bsz, seq, RET_HEADS, RET_VAL_DIM)
    return qa, ka, va, qr, kr, vr, gr


def window_attention_prompt(q, k, v, sinks, rel_table):
    bsz, seq = q.shape[:2]
    nc = seq // CHUNK
    qc = q.reshape(bsz, nc, CHUNK, ATT_KV_HEADS, ATT_GROUP, ATT_HEAD_DIM)
    pad = ((0, 0), (BAND_CHUNKS * CHUNK, 0), (0, 0), (0, 0))
    kp = jnp.pad(k, pad).reshape(bsz, nc + BAND_CHUNKS, CHUNK, ATT_KV_HEADS, ATT_HEAD_DIM)
    vp = jnp.pad(v, pad).reshape(bsz, nc + BAND_CHUNKS, CHUNK, ATT_KV_HEADS, ATT_HEAD_DIM)
    kb = jnp.concatenate([kp[:, j:j + nc] for j in range(BAND_CHUNKS + 1)], axis=2)
    vb = jnp.concatenate([vp[:, j:j + nc] for j in range(BAND_CHUNKS + 1)], axis=2)
    s = jnp.einsum('bcikgd,bcjkd->bckgij', qc, kb).astype(jnp.float32) * ATT_SCALE
    qi = jnp.arange(CHUNK)
    kj = jnp.arange(BAND) - BAND_CHUNKS * CHUNK
    s = s + relative_bias(kj[None, :] - qi[:, None], rel_table)
    key_chunk = jnp.arange(nc)[:, None] + (jnp.arange(BAND) // CHUNK - BAND_CHUNKS)[None, :]
    s = jnp.where((key_chunk >= 0)[None, :, None, None, None, :], s, -jnp.inf)
    p = sink_softmax(s, sinks)
    o = jnp.einsum('bckgij,bcjkd->bcikgd', p.astype(vb.dtype), vb)
    return o.reshape(bsz, seq, ATT_Q_W)


def window_attention_sample(q, k_all, v_all, n_cache, sinks, rel_table):
    dbsz, n = q.shape[:2]
    qg = q.reshape(dbsz, n, ATT_KV_HEADS, ATT_GROUP, ATT_HEAD_DIM)
    s = jnp.einsum('bikgd,bjkd->bkgij', qg, k_all).astype(jnp.float32) * ATT_SCALE
    qpos = PAST_LEN + jnp.arange(n)
    kpos = PAST_LEN - n_cache + jnp.arange(n_cache + n)
    s = s + relative_bias(kpos[None, :] - qpos[:, None], rel_table)
    p = sink_softmax(s, sinks)
    o = jnp.einsum('bkgij,bjkd->bikgd', p.astype(v_all.dtype), v_all)
    return o.reshape(dbsz, n, ATT_Q_W)


def ret_log_decay():
    return jnp.log(1.0 - 2.0 ** (-5.0 - jnp.arange(RET_HEADS, dtype=jnp.float32)))


def causal_decay(n, log_g):
    i = jnp.arange(n)
    diff = (i[:, None] - i[None, :]).astype(jnp.float32)
    mask = diff >= 0
    return jnp.where(mask[None], jnp.exp(jnp.where(mask, diff, 0.0)[None] * log_g[:, None, None]), 0.0)


def retention_prompt(q, k, v):
    bsz, seq = q.shape[:2]
    nc = seq // CHUNK
    log_g = ret_log_decay()
    qc = q.astype(jnp.float32).reshape(bsz, nc, CHUNK, RET_HEADS, RET_KEY_DIM)
    kc = k.astype(jnp.float32).reshape(bsz, nc, CHUNK, RET_HEADS, RET_KEY_DIM)
    vc = v.astype(jnp.float32).reshape(bsz, nc, CHUNK, RET_HEADS, RET_VAL_DIM)
    pos = jnp.arange(CHUNK, dtype=jnp.float32)
    scores = jnp.einsum('bcihd,bcjhd->bchij', qc, kc) * causal_decay(CHUNK, log_g)
    intra = jnp.einsum('bchij,bcjhe->bcihe', scores, vc)
    kdec = jnp.exp((CHUNK - 1.0 - pos)[:, None] * log_g[None, :])
    delta = jnp.einsum('bcjhd,bcjhe->cbhde', kc * kdec[:, :, None], vc)
    chunk_decay = jnp.exp(CHUNK * log_g)[None, :, None, None]

    def step(s_prev, d):
        return chunk_decay * s_prev + d, s_prev

    s0 = jnp.zeros((bsz, RET_HEADS, RET_KEY_DIM, RET_VAL_DIM), jnp.float32)
    s_final, s_before = lax.scan(step, s0, delta)
    qdec = jnp.exp((pos + 1.0)[:, None] * log_g[None, :])
    inter = jnp.einsum('bcihd,cbhde->bcihe', qc * qdec[:, :, None], s_before)
    return (intra + inter).reshape(bsz, seq, RET_HEADS, RET_VAL_DIM), s_final


def retention_sample(q, k, v, s0):
    n = q.shape[1]
    log_g = ret_log_decay()
    qf, kf, vf = q.astype(jnp.float32), k.astype(jnp.float32), v.astype(jnp.float32)
    s0f = s0.astype(jnp.float32)
    pos = jnp.arange(n, dtype=jnp.float32)
    scores = jnp.einsum('bihd,bjhd->bhij', qf, kf) * causal_decay(n, log_g)
    intra = jnp.einsum('bhij,bjhe->bihe', scores, vf)
    qdec = jnp.exp((pos + 1.0)[:, None] * log_g[None, :])
    inter = jnp.einsum('bihd,bhde->bihe', qf * qdec[:, :, None], s0f)
    kdec = jnp.exp((n - 1.0 - pos)[:, None] * log_g[None, :])
    s_new = jnp.exp(n * log_g)[None, :, None, None] * s0f + jnp.einsum('bjhd,bjhe->bhde', kf * kdec[:, :, None], vf)
    return intra + inter, s_new


def merge_heads(att_o, ret_o, gr, w_out):
    bsz, seq = att_o.shape[:2]
    r = ret_o * lax.rsqrt(jnp.mean(ret_o * ret_o, axis=-1, keepdims=True) + EPS)
    r = r.reshape(bsz, seq, RET_V_W).astype(gr.dtype) * jax.nn.silu(gr)
    mixed = jnp.concatenate([att_o.astype(gr.dtype), r], axis=-1)
    return jnp.einsum('bse,ed->bsd', mixed, w_out)


def squared_relu_mlp(h, w_up, w_down):
    u = jnp.einsum('bsd,df->bsf', h, w_up)
    return jnp.einsum('bsf,fd->bsd', jnp.square(jax.nn.relu(u)), w_down)


def setup_inputs(seed: int = 0) -> dict:
    key = jax.random.key(seed)
    ks = jax.random.split(key, 20)
    f32 = jnp.float32
    keep = min(WINDOW, PAST_LEN)

    def nrm(k, shape, scale):
        return jax.random.normal(k, shape, f32) * scale

    return {
        'x_prompt': nrm(ks[0], (BATCH, SEQ, D_MODEL), 1.0),
        'x_sample': nrm(ks[1], (DEC_BATCH, DEC_SEQ, D_MODEL), 1.0),
        'c_prompt': nrm(ks[2], (BATCH, D_MODEL), 1.0),
        'c_sample': nrm(ks[3], (DEC_BATCH, D_MODEL), 1.0),
        'cache_win_k': nrm(ks[4], (DEPTH, DEC_BATCH, keep, ATT_KV_HEADS, ATT_HEAD_DIM), 1.0),
        'cache_win_v': nrm(ks[5], (DEPTH, DEC_BATCH, keep, ATT_KV_HEADS, ATT_HEAD_DIM), 1.0),
        'state_ret': nrm(ks[6], (DEPTH, DEC_BATCH, RET_HEADS, RET_KEY_DIM, RET_VAL_DIM), 0.5),
        'g_mix': 1.0 + nrm(ks[7], (DEPTH, D_MODEL), 0.1),
        'g_mlp': 1.0 + nrm(ks[8], (DEPTH, D_MODEL), 0.1),
        'w_ada': nrm(ks[9], (DEPTH, D_MODEL, N_MOD * D_MODEL), D_MODEL ** -0.5),
        'b_ada': nrm(ks[10], (DEPTH, N_MOD * D_MODEL), 0.1),
        'w_in': nrm(ks[11], (DEPTH, D_MODEL, IN_W), D_MODEL ** -0.5),
        'w_out': nrm(ks[12], (DEPTH, MIX_W, D_MODEL), MIX_W ** -0.5),
        'att_sinks': nrm(ks[13], (DEPTH, ATT_HEADS), 1.0),
        'rel_bias': nrm(ks[14], (REL_BUCKETS, ATT_HEADS), 0.3),
        'w_up': nrm(ks[15], (DEPTH, D_MODEL, D_FF), D_MODEL ** -0.5),
        'w_down': nrm(ks[16], (DEPTH, D_FF, D_MODEL), D_FF ** -0.5),
        'g_final': 1.0 + nrm(ks[17], (D_MODEL,), 0.1),
    }


def reference(x_prompt, x_sample, c_prompt, c_sample, cache_win_k, cache_win_v, state_ret,
              g_mix, g_mlp, w_ada, b_ada, w_in, w_out, att_sinks, rel_bias, w_up, w_down, g_final):
    seq = x_prompt.shape[1]
    dec_seq = x_sample.shape[1]
    n_cache = cache_win_k.shape[2]
    keep_p = min(WINDOW, seq)
    pos_p = jnp.arange(seq)
    pos_s = PAST_LEN + jnp.arange(dec_seq)
    xp, xs = x_prompt, x_sample
    pk, pv, pr, sk, sv, sr = [], [], [], [], [], []
    for l in range(DEPTH):
        sh1p, sc1p, ga1p, sh2p, sc2p, ga2p = ada_params(c_prompt, w_ada[l], b_ada[l])
        sh1s, sc1s, ga1s, sh2s, sc2s, ga2s = ada_params(c_sample, w_ada[l], b_ada[l])

        h = modulate(xp, g_mix[l], sh1p, sc1p)
        qa, ka, va, qr, kr, vr, gr = project(h, w_in[l], pos_p)
        ao = window_attention_prompt(qa, ka, va, att_sinks[l], rel_bias)
        ro, st = retention_prompt(qr, kr, vr)
        xp = xp + ga1p[:, None, :] * merge_heads(ao, ro, gr, w_out[l])
        xp = xp + ga2p[:, None, :] * squared_relu_mlp(modulate(xp, g_mlp[l], sh2p, sc2p), w_up[l], w_down[l])
        pk.append(ka[:, seq - keep_p:])
        pv.append(va[:, seq - keep_p:])
        pr.append(st)

        h = modulate(xs, g_mix[l], sh1s, sc1s)
        qa, ka, va, qr, kr, vr, gr = project(h, w_in[l], pos_s)
        k_all = jnp.concatenate([cache_win_k[l].astype(ka.dtype), ka], axis=1)
        v_all = jnp.concatenate([cache_win_v[l].astype(va.dtype), va], axis=1)
        ao = window_attention_sample(qa, k_all, v_all, n_cache, att_sinks[l], rel_bias)
        ro, st = retention_sample(qr, kr, vr, state_ret[l])
        xs = xs + ga1s[:, None, :] * merge_heads(ao, ro, gr, w_out[l])
        xs = xs + ga2s[:, None, :] * squared_relu_mlp(modulate(xs, g_mlp[l], sh2s, sc2s), w_up[l], w_down[l])
        total = n_cache + dec_seq
        sk.append(k_all[:, total - n_cache:])
        sv.append(v_all[:, total - n_cache:])
        sr.append(st)

    y_prompt = rms_norm(xp, g_final)
    y_sample = rms_norm(xs, g_final)
    return (y_prompt, y_sample, jnp.stack(pk), jnp.stack(pv), jnp.stack(pr), jnp.stack(sk), jnp.stack(sv), jnp.stack(sr))
```

```cpp
#include <hip/hip_runtime.h>
#include <hip/hip_cooperative_groups.h>
#include <cstdio>
#include <cstdint>
namespace cg = cooperative_groups;

namespace pg8 {
#define PG8_LAS __attribute__((address_space(3)))
typedef unsigned short bf16_t;
typedef short bf16x8 __attribute__((ext_vector_type(8)));
typedef float f32x4 __attribute__((ext_vector_type(4)));
typedef unsigned u32x4 __attribute__((ext_vector_type(4)));
constexpr int BM = 256, BK = 64, HALF = 128, HTB = HALF * BK * 2  , STAGE_BYTES = 8 * HTB, NXCD = 8, WGM = 8;

__host__ __device__ __forceinline__ int lds_byte(int r, int c) { const int st = (r >> 4) * 2 + (c >> 5), rr = r & 15, cc = c & 31, ob = rr * 64 + cc * 2; return st * 1024 + (ob ^ (((ob >> 9) & 1) << 5)); }
__host__ __device__ __forceinline__ void stage_rc(int b, int& R, int& C) { const int st = b / 1024, sb = b % 1024, swz = sb ^ (((sb >> 9) & 1) << 5); R = (st >> 1) * 16 + swz / 64; C = (st & 1) * 32 + (swz % 64) / 2; }
__host__ __device__ __forceinline__ int perm32(int rho) { const int n = rho >> 4, i = rho & 15; return 8 * (i >> 2) + 4 * n + (i & 3); }

struct Unit { int pm, pn, koff; };
struct Gemm { const bf16_t* A; const bf16_t* Bt; int M, N, K, ld, pf; const char* px; };

struct StaticOrder {
    int nM, nN, nwg, G, c, pm0, ks, kbytes;
    __host__ __device__ void init(int M, int N, int G_, int c_, int pm0_ = 0, int ks_ = 1, int kbytes_ = 0) { nM = M / BM; nN = N / BM; ks = ks_; nwg = nM * nN * ks; G = G_; c = c_; pm0 = pm0_; kbytes = kbytes_; }
    __host__ __device__ bool next(int i, Unit& u) const {
        const long L = (long)i * G + c; if (L >= nwg) return false;
        if (ks > 1) { const int sub = (int)L % ks, tile = (int)L / ks; u.pm = pm0 + tile % nM; u.pn = tile / nM; u.koff = sub * kbytes; return true; }
        int wgid = (int)L; { const int q = nwg / NXCD, r = nwg % NXCD, xcd = wgid % NXCD, off = wgid / NXCD; wgid = (xcd < r ? xcd * (q + 1) : r * (q + 1) + (xcd - r) * q) + off; }
        const int nig = WGM * nN, gid = wgid / nig, fm = gid * WGM, gsz = (nM - fm) < WGM ? (nM - fm) : WGM;
        u.pm = pm0 + fm + ((wgid % nig) % gsz); u.pn = (wgid % nig) / gsz; u.koff = 0; return true;
    }
    __device__ __forceinline__ void a_ready(const Unit&) const {}
    __device__ __forceinline__ void done(const Unit&) const {}
};
typedef float f32x2 __attribute__((ext_vector_type(2)));
typedef unsigned u32x2 __attribute__((ext_vector_type(2)));
typedef __bf16 bf16v2 __attribute__((ext_vector_type(2)));
__device__ __forceinline__ unsigned pk2(float lo, float hi) { const f32x2 v = {lo, hi}; return __builtin_bit_cast(unsigned, __builtin_convertvector(v, bf16v2)); }
template <class Epi, class Sched, bool ALIGN_EPI = false, bool SP2 = false>
__device__ __forceinline__ void gemm_phase(PG8_LAS unsigned char* lds, const Gemm g, const Sched& S, const Epi& E, const int tid) {
    const int wid = __builtin_amdgcn_readfirstlane(tid >> 6), lane = tid & 63, wr = wid >> 2, wc = wid & 3, fr = lane & 15, fq = lane >> 4;
    const int K = g.K, nt = K / BK;
    unsigned voffA, voffB;
    { int R, C; stage_rc(tid * 16, R, C); const int Rb = E.perm() ? ((R & ~31) + perm32(R & 31)) : R;
        voffA = (unsigned)(R * g.ld + C) * 2u; voffB = (unsigned)(Rb * g.ld + C) * 2u; }
    const size_t qstep = (size_t)64 * g.ld * 2;
    const size_t kstep = (size_t)(BK * 2);
    const size_t hstep = (size_t)HALF * g.ld * 2;
    const size_t tstep = 2 * hstep;
    const unsigned ldsw = (unsigned)wid * 1024u;
    const int aoff = lds_byte(wr * 64 + fr, fq * 8), boff = lds_byte(wc * 32 + fr, fq * 8);
#define PG8_SA(b, h) (((b) * 2 + (h)) * HTB)
#define PG8_SB(b, h) ((4 + (b) * 2 + (h)) * HTB)
#define PG8_STAGE(bufoff, gbase, voff) do { _Pragma("unroll") for (int _i = 0; _i < 2; ++_i) \
        __builtin_amdgcn_global_load_lds((const unsigned*)((const char*)(gbase) + _i * qstep + (voff)), (PG8_LAS unsigned*)(lds + (bufoff) + ldsw + _i * 8192), 16, 0, 0); } while (0)
#define PG8_LDA(dst, b, h) do { _Pragma("unroll") for (int m = 0; m < 4; ++m) _Pragma("unroll") for (int k = 0; k < 2; ++k) dst[m][k] = *(const PG8_LAS bf16x8*)(lds + PG8_SA(b, h) + aoff + m * 2048 + k * 1024); } while (0)
#define PG8_LDB(dst, b, h) do { _Pragma("unroll") for (int n = 0; n < 2; ++n) _Pragma("unroll") for (int k = 0; k < 2; ++k) dst[n][k] = *(const PG8_LAS bf16x8*)(lds + PG8_SB(b, h) + boff + n * 2048 + k * 1024); } while (0)
#define PG8_MMA(ai, bj, At, Bt) do { __builtin_amdgcn_s_setprio(1); _Pragma("unroll") for (int m = 0; m < 4; ++m) _Pragma("unroll") for (int n = 0; n < 2; ++n) _Pragma("unroll") for (int k = 0; k < 2; ++k) \
        acc[ai][bj][m][n] = __builtin_amdgcn_mfma_f32_16x16x32_bf16(Bt[n][k], At[m][k], acc[ai][bj][m][n], 0, 0, 0); __builtin_amdgcn_s_setprio(0); } while (0)
#define PG8_WAIT_V(n) asm volatile("s_waitcnt vmcnt(" #n ")" ::: "memory")
#define PG8_WAIT_L(n) asm volatile("s_waitcnt lgkmcnt(" #n ")" ::: "memory")
#define PG8_BAR __builtin_amdgcn_s_barrier()
#define PG8_SCHED __builtin_amdgcn_sched_barrier(0)
    Unit cur, nxt; int ui = 0;
    if (!S.next(0, cur)) return;
    f32x4 acc[2][2][4][2];
#pragma unroll
    for (int a = 0; a < 2; ++a)
#pragma unroll
        for (int b = 0; b < 2; ++b)
#pragma unroll
            for (int m = 0; m < 4; ++m)
#pragma unroll
                for (int n = 0; n < 2; ++n) acc[a][b][m][n] = (f32x4){0.f, 0.f, 0.f, 0.f};
    bf16x8 At[4][2], B0[2][2], B1[2][2];
    const char* cA = (const char*)g.A + (size_t)cur.pm * tstep + cur.koff; const char* cB = (const char*)g.Bt + (size_t)cur.pn * tstep + cur.koff;
    S.a_ready(cur);
    if constexpr (SP2) {
        PG8_STAGE(PG8_SB(0, 0), cB, voffB); PG8_STAGE(PG8_SB(0, 1), cB + hstep, voffB); PG8_STAGE(PG8_SA(0, 0), cA, voffA); PG8_STAGE(PG8_SA(0, 1), cA + hstep, voffA);
        if (wr == 1) PG8_BAR;
        PG8_WAIT_V(2); PG8_BAR;
        PG8_STAGE(PG8_SB(1, 0), cB + kstep, voffB); PG8_STAGE(PG8_SA(1, 0), cA + kstep, voffA); PG8_STAGE(PG8_SB(1, 1), cB + hstep + kstep, voffB);
        PG8_WAIT_V(6); PG8_BAR;
    } else {
        PG8_STAGE(PG8_SB(0, 0), cB, voffB); PG8_STAGE(PG8_SA(0, 0), cA, voffA); PG8_STAGE(PG8_SB(0, 1), cB + hstep, voffB); PG8_STAGE(PG8_SA(0, 1), cA + hstep, voffA);
        if (wr == 1) PG8_BAR;
        PG8_WAIT_V(4); PG8_BAR;
        PG8_STAGE(PG8_SB(1, 0), cB + kstep, voffB); PG8_STAGE(PG8_SA(1, 0), cA + kstep, voffA); PG8_STAGE(PG8_SB(1, 1), cB + hstep + kstep, voffB);
        PG8_WAIT_V(6); PG8_BAR;
    }
    for (;;) {
        const bool has_next = S.next(ui + 1, nxt);
        const char* nA = has_next ? (const char*)g.A + (size_t)nxt.pm * tstep + nxt.koff : cA; const char* nB = has_next ? (const char*)g.Bt + (size_t)nxt.pn * tstep + nxt.koff : cB;
        for (int t = 0; t < nt; t += 2) {
            const bool last = (t == nt - 2);
            const char* a1 = cA + (size_t)(t + 1) * kstep;
            const char* a2 = last ? nA : cA + (size_t)(t + 2) * kstep; const char* b2 = last ? nB : cB + (size_t)(t + 2) * kstep;
            const char* a3 = a2 + kstep; const char* b3 = b2 + kstep;
            if (last && has_next) S.a_ready(nxt);
            if (g.px && t == nt - 8) {
                unsigned zz = 0u; asm volatile("" : "+v"(zz));
                const unsigned tix = ((unsigned)wid << 6) + __builtin_amdgcn_mbcnt_hi(~0u, __builtin_amdgcn_mbcnt_lo(~0u, zz));
                const char* sb = g.px + (size_t)cur.pm * 256 * (size_t)g.pf + (size_t)cur.pn * 512;
                const char* p = sb + ((tix >> 1) * (unsigned)g.pf + (tix & 1u) * 256u);
                __builtin_amdgcn_global_load_lds((const unsigned*)p, (PG8_LAS unsigned*)(lds + STAGE_BYTES + 2048 + wid * 256), 4, 0, 0);
                __builtin_amdgcn_global_load_lds((const unsigned*)(p + 128), (PG8_LAS unsigned*)(lds + STAGE_BYTES + 2048 + wid * 256), 4, 0, 0);
            }
            if constexpr (SP2) {
            PG8_LDB(B0, 0, 0); PG8_LDB(B1, 0, 1); PG8_SCHED; PG8_LDA(At, 0, 0); PG8_STAGE(PG8_SA(1, 1), a1 + hstep, voffA);
            PG8_WAIT_V(8); PG8_WAIT_L(0); PG8_BAR; PG8_MMA(0, 0, At, B0); PG8_MMA(0, 1, At, B1); PG8_BAR; PG8_SCHED;
            PG8_LDA(At, 0, 1); PG8_STAGE(PG8_SB(0, 0), b2, voffB); PG8_STAGE(PG8_SB(0, 1), b2 + hstep, voffB); PG8_STAGE(PG8_SA(0, 0), a2, voffA);
            PG8_WAIT_V(8); PG8_WAIT_L(0); PG8_BAR; PG8_MMA(1, 0, At, B0); PG8_MMA(1, 1, At, B1); PG8_BAR; PG8_SCHED;
            PG8_LDB(B0, 1, 0); PG8_LDB(B1, 1, 1); PG8_SCHED; PG8_LDA(At, 1, 0); PG8_STAGE(PG8_SA(0, 1), a2 + hstep, voffA);
            PG8_WAIT_V(8); PG8_WAIT_L(0); PG8_BAR; PG8_MMA(0, 0, At, B0); PG8_MMA(0, 1, At, B1); PG8_BAR; PG8_SCHED;
            PG8_LDA(At, 1, 1); PG8_STAGE(PG8_SB(1, 0), b3, voffB); PG8_STAGE(PG8_SB(1, 1), b3 + hstep, voffB); PG8_STAGE(PG8_SA(1, 0), a3, voffA);
            PG8_WAIT_V(8); PG8_WAIT_L(0); PG8_BAR; PG8_MMA(1, 0, At, B0); PG8_MMA(1, 1, At, B1); PG8_BAR; PG8_SCHED;
            } else {
            PG8_LDB(B0, 0, 0); PG8_SCHED; PG8_LDA(At, 0, 0); PG8_STAGE(PG8_SA(1, 1), a1 + hstep, voffA);
            PG8_WAIT_L(8); PG8_BAR; PG8_WAIT_L(0); PG8_MMA(0, 0, At, B0); PG8_BAR; PG8_SCHED;
            PG8_LDB(B1, 0, 1); PG8_STAGE(PG8_SB(0, 0), b2, voffB);
            PG8_BAR; PG8_WAIT_L(0); PG8_MMA(0, 1, At, B1); PG8_BAR;
            PG8_LDA(At, 0, 1); PG8_STAGE(PG8_SA(0, 0), a2, voffA);
            PG8_BAR; PG8_WAIT_L(0); PG8_MMA(1, 0, At, B0); PG8_BAR; PG8_SCHED;
            PG8_STAGE(PG8_SB(0, 1), b2 + hstep, voffB);
            PG8_WAIT_V(6); PG8_BAR; PG8_MMA(1, 1, At, B1); PG8_BAR;
            PG8_LDB(B0, 1, 0); PG8_SCHED; PG8_LDA(At, 1, 0); PG8_STAGE(PG8_SA(0, 1), a2 + hstep, voffA);
            PG8_WAIT_L(8); PG8_BAR; PG8_WAIT_L(0); PG8_MMA(0, 0, At, B0); PG8_BAR; PG8_SCHED;
            PG8_LDB(B1, 1, 1); PG8_STAGE(PG8_SB(1, 0), b3, voffB);
            PG8_BAR; PG8_WAIT_L(0); PG8_MMA(0, 1, At, B1); PG8_BAR;
            PG8_LDA(At, 1, 1); PG8_STAGE(PG8_SA(1, 0), a3, voffA);
            PG8_BAR; PG8_WAIT_L(0); PG8_MMA(1, 0, At, B0); PG8_BAR; PG8_SCHED;
            PG8_STAGE(PG8_SB(1, 1), b3 + hstep, voffB);
            PG8_WAIT_V(6); PG8_BAR; PG8_MMA(1, 1, At, B1); PG8_BAR;
            }
        }
        if constexpr (ALIGN_EPI) { if (wr == 0) PG8_BAR; }
        if constexpr (!Epi::AFTER_DRAIN) { E(acc, cur, wr, wc, fr, fq); S.done(cur); }
        if (!has_next) break;
#pragma unroll
        for (int a = 0; a < 2; ++a)
#pragma unroll
            for (int b = 0; b < 2; ++b)
#pragma unroll
                for (int m = 0; m < 4; ++m)
#pragma unroll
                    for (int n = 0; n < 2; ++n) acc[a][b][m][n] = (f32x4){0.f, 0.f, 0.f, 0.f};
        cur = nxt; cA = nA; cB = nB; ++ui;
        if constexpr (ALIGN_EPI) { if (wr == 1) PG8_BAR; }
    }
    PG8_WAIT_V(0);
    if constexpr (!ALIGN_EPI) { if (wr == 0) PG8_BAR; }
    PG8_BAR;
    if constexpr (Epi::AFTER_DRAIN) { E.fused(acc, cur, wr, wc, fr, fq, lds, wid, lane); S.done(cur); }
#undef PG8_SA
#undef PG8_SB
#undef PG8_STAGE
#undef PG8_LDA
#undef PG8_LDB
#undef PG8_MMA
#undef PG8_WAIT_V
#undef PG8_WAIT_L
#undef PG8_BAR
#undef PG8_SCHED
}
}

#define LAS __attribute__((address_space(3)))
typedef unsigned short bf16;
typedef float f32x4 __attribute__((ext_vector_type(4)));
typedef float f32x16 __attribute__((ext_vector_type(16)));
typedef short bf16x8 __attribute__((ext_vector_type(8)));
typedef short s16x4 __attribute__((ext_vector_type(4)));
typedef unsigned u32x4 __attribute__((ext_vector_type(4)));
using pg8::f32x2; using pg8::u32x2; using pg8::pk2;

constexpr int DM = 1024, SEQ = 16384, NBP = 2, MP = NBP * SEQ, DBS = 32, DSQ = 16, MS = DBS * DSQ, MT = MP + MS;
constexpr int NBT = NBP + DBS;
constexpr int INW = 2816, DFF = 4096, NMOD = 6 * DM, NLAYER = 2;
constexpr int CS_ROWS = SEQ + DSQ;
constexpr float LOG2E = 1.4426950408889634f, QSCALE = 0.18033688011112042f  , KSCALE = 0.08838834764831845f  , EPS = 1e-6f;
constexpr int LDH = DFF + 64;
constexpr int NTILE_B = SEQ / 256;

enum { I_XP = 0, I_XS, I_CP, I_CS, I_CK, I_CV, I_SR, I_GMIX, I_GMLP, I_WADA, I_BADA, I_WIN, I_WOUT, I_SINK, I_RELB, I_WUP, I_WDN, I_GFIN };
constexpr size_t O_Y = 0, O_WKP = (size_t)MT * DM, O_WVP = O_WKP + 65536, O_RSP = O_WVP + 65536, O_WKS = O_RSP + 262144, O_WVS = O_WKS + 1048576, O_RSS = O_WVS + 1048576, O_END = O_RSS + 4194304;

constexpr size_t al256(size_t x) { return (x + 255) & ~(size_t)255; }
constexpr size_t WS_CTL = 0, CTL_ZERO_BYTES = 16384;
constexpr size_t WS_BT = 16384;
constexpr size_t WS_MOD = 65536;
constexpr size_t WS_CS = al256(WS_MOD + (size_t)NLAYER * NBT * NMOD * 4);
constexpr size_t WS_WIN = al256(WS_CS + (size_t)CS_ROWS * 64 * 8);
constexpr size_t WS_WOUT = al256(WS_WIN + (size_t)NLAYER * INW * DM * 2);
constexpr size_t WS_WUP = al256(WS_WOUT + (size_t)NLAYER * DM * DM * 2);
constexpr size_t WS_WDN = al256(WS_WUP + (size_t)NLAYER * DFF * DM * 2);
constexpr size_t WS_SS0 = al256(WS_WDN + (size_t)NLAYER * DM * LDH * 2);
constexpr size_t WS_XG = al256(WS_SS0 + (size_t)NLAYER * DBS * 4 * 16384 * 2);
constexpr size_t WS_U = al256(WS_XG + (size_t)MT * DM * 2);
constexpr size_t WS_MIX = al256(WS_U + (size_t)(MT + 64) * INW * 2);
constexpr size_t WS_DT = al256(WS_MIX + (size_t)MT * DM * 2);
constexpr size_t WS_SST = al256(WS_DT + (size_t)NBP * NTILE_B * 4 * 16384 * 4);
constexpr size_t WS_XB = al256(WS_SST + (size_t)NBP * NTILE_B * 4 * 16384 * 2);
constexpr size_t WS_SSP = al256(WS_XB + (size_t)MS * DM * 2);
constexpr size_t WS_SHM = al256(WS_SSP + (size_t)2 * MT * 4);
constexpr size_t WS_GS = al256(WS_SHM + (size_t)NLAYER * 2 * 256 * DM * 2);
constexpr size_t WS_GSI = al256(WS_GS + (size_t)(NLAYER * 2 + 1) * NBT * DM * 4);
constexpr size_t WS_C1 = al256(WS_GSI + (size_t)(NLAYER * 2) * NBT * DM * 4);
constexpr size_t WS_C2 = al256(WS_C1 + (size_t)NLAYER * NBT * INW * 4);
constexpr int KS2 = 4, KS4 = 16;
constexpr size_t WS_Y2 = al256(WS_C2 + (size_t)NLAYER * NBT * DFF * 4);
constexpr size_t WS_Y4 = al256(WS_Y2 + (size_t)KS2 * MS * DM * 4);
constexpr size_t WS_END = al256(WS_Y4 + (size_t)KS4 * MS * DM * 4);
constexpr size_t WS_HID = WS_U;
static_assert(WS_HID + (size_t)MT * LDH * 2 <= WS_SST && WS_END <= (size_t)512 * 1024 * 1024, "HID overlay fits; the map stays under 512 MiB");

constexpr int LDS_BYTES = 147456;
constexpr int MISC_OFF = LDS_BYTES - 256;

__device__ __forceinline__ int row_bidx(int r) { return r < MP ? (r >> 14) : NBP + ((r - MP) >> 4); }
__device__ __forceinline__ int row_csidx(int r) { return r < MP ? (r & (SEQ - 1)) : SEQ + (r & 15); }
__device__ __forceinline__ float bf2f(unsigned short b) { return __uint_as_float(((unsigned)b) << 16); }
__device__ __forceinline__ float wave_sum(float v) {
#pragma unroll
    for (int o = 1; o < 64; o <<= 1) v += __shfl_xor(v, o);
    return v;
}
__device__ __forceinline__ int crow(int r, int h) { return (r & 3) + 8 * (r >> 2) + 4 * h; }
__device__ __forceinline__ float log2gamma(int h) { return h == 0 ? -0.04580368961312479f : h == 1 ? -0.02272007650008353f : h == 2 ? -0.011315313227834146f : -0.005646563141142063f; }
__device__ __forceinline__ int rel_bucket(int rel) {
    const int n = rel < 0 ? -rel : rel; const int base = rel > 0 ? 16 : 0;
    int v;
    if (n < 8) v = n; else if (n < 12) v = 8; else if (n < 16) v = 9; else if (n < 23) v = 10; else if (n < 32) v = 11; else if (n < 46) v = 12; else if (n < 64) v = 13; else if (n < 91) v = 14; else v = 15;
    return base + v;
}
#define MFMA32(a, b, c) __builtin_amdgcn_mfma_f32_32x32x16_bf16((a), (b), (c), 0, 0, 0)

__device__ __forceinline__ float row_rstd(const float* ss, int row) { return __builtin_amdgcn_rsqf(ss[row] * (1.0f / DM) + EPS); }
struct EpiG1 {
    bf16* U; const float* cs; float* wkp; float* wvp; float* wks; float* wvs; const float* ss; const float* cv;
    template <bool UNI> __device__ __forceinline__ void run(const pg8::f32x4 (&acc)[2][2][4][2], const pg8::Unit& u, int wr, int wc, int fr, int fq) const {
        const int pn = u.pn, rowb = u.pm * 256 + wr * 64 + fr, colq = pn * 256 + wc * 32 + 8 * fq;
        pg8::f32x4 cu[2][2];
        if (UNI) { const float* cb = cv + (size_t)(u.pm >> 6) * INW + colq;
#pragma unroll
            for (int bj = 0; bj < 2; ++bj) { cu[bj][0] = *(const pg8::f32x4*)(cb + bj * 128); cu[bj][1] = *(const pg8::f32x4*)(cb + bj * 128 + 4); } }
        if (pn >= 3 && pn <= 6) {
            const float ksc = pn >= 5 ? KSCALE : 1.f; const int g = 4 * wc + fq;
#pragma unroll
            for (int ai = 0; ai < 2; ++ai)
#pragma unroll
                for (int m = 0; m < 4; ++m) {
                    const int row = rowb + ai * 128 + m * 16;
                    const float rs = row_rstd(ss, row); const float* cb = cv + (size_t)row_bidx(row) * INW + colq;
                    const pg8::f32x4* cp = (const pg8::f32x4*)(cs + ((size_t)row_csidx(row) * 64 + 4 * g) * 2);
                    const pg8::f32x4 c01 = cp[0], c23 = cp[1];
                    const float co[4] = {c01.x, c01.z, c23.x, c23.z}, si[4] = {c01.y, c01.w, c23.y, c23.w};
#pragma unroll
                    for (int bj = 0; bj < 2; ++bj) {
                        const pg8::f32x4 b0 = UNI ? cu[bj][0] : *(const pg8::f32x4*)(cb + bj * 128), b1 = UNI ? cu[bj][1] : *(const pg8::f32x4*)(cb + bj * 128 + 4);
                        const pg8::f32x4 x1 = acc[ai][bj][m][0] * rs + b0, x2 = acc[ai][bj][m][1] * rs + b1; float o1[4], o2[4];
#pragma unroll
                        for (int j = 0; j < 4; ++j) { o1[j] = (x1[j] * co[j] - x2[j] * si[j]) * ksc; o2[j] = (x2[j] * co[j] + x1[j] * si[j]) * ksc; }
                        bf16* p = U + (size_t)row * INW + pn * 256 + bj * 128 + 4 * g;
                        u32x2 w1, w2; w1.x = pk2(o1[0], o1[1]); w1.y = pk2(o1[2], o1[3]); w2.x = pk2(o2[0], o2[1]); w2.y = pk2(o2[2], o2[3]);
                        { const auto r0 = __builtin_amdgcn_permlane16_swap(w1.x, w2.x, false, false), r1 = __builtin_amdgcn_permlane16_swap(w1.y, w2.y, false, false);
                          u32x4 w; w.x = r0[0]; w.y = r1[0]; w.z = r0[1]; w.w = r1[1];
                          *(u32x4*)(p + ((fq & 1) ? 60 : 0)) = w; }
                    }
                }
        } else {
            const float sc = pn < 2 ? QSCALE : 1.f;
            const bool win = pn == 2 && (u.pm >= MP / 256 || (u.pm & (SEQ / 256 - 1)) == SEQ / 256 - 1);
            if (pn >= 9) plain<UNI, 1>(acc, u, wr, wc, fr, fq, cu, sc); else if (win) plain<UNI, 2>(acc, u, wr, wc, fr, fq, cu, sc); else plain<UNI, 0>(acc, u, wr, wc, fr, fq, cu, sc);
        }
    }
    template <bool UNI, int MODE> __device__ __forceinline__ void plain(const pg8::f32x4 (&acc)[2][2][4][2], const pg8::Unit& u, int wr, int wc, int fr, int fq, const pg8::f32x4 (&cu)[2][2], float sc) const {
        const int pn = u.pn, rowb = u.pm * 256 + wr * 64 + fr, colq = pn * 256 + wc * 32 + 8 * fq;
#pragma unroll
        for (int ai = 0; ai < 2; ++ai)
#pragma unroll
            for (int m = 0; m < 4; ++m) {
                const int row = rowb + ai * 128 + m * 16;
                const float rs = row_rstd(ss, row); const float* cb = cv + (size_t)row_bidx(row) * INW + colq;
#pragma unroll
                for (int bj = 0; bj < 2; ++bj) {
                    const pg8::f32x4 b0 = UNI ? cu[bj][0] : *(const pg8::f32x4*)(cb + bj * 128), b1 = UNI ? cu[bj][1] : *(const pg8::f32x4*)(cb + bj * 128 + 4);
                    const pg8::f32x4 a0 = acc[ai][bj][m][0] * rs + b0, a1 = acc[ai][bj][m][1] * rs + b1;
                    pg8::f32x4 v0 = a0 * sc, v1 = a1 * sc;
                    if (MODE == 1) {
#pragma unroll
                        for (int j = 0; j < 4; ++j) { v0[j] = v0[j] * __builtin_amdgcn_rcpf(1.f + __expf(-v0[j])); v1[j] = v1[j] * __builtin_amdgcn_rcpf(1.f + __expf(-v1[j])); }
                    }
                    u32x4 w; w.x = pk2(v0[0], v0[1]); w.y = pk2(v0[2], v0[3]); w.z = pk2(v1[0], v1[1]); w.w = pk2(v1[2], v1[3]);
                    *(u32x4*)(U + (size_t)row * INW + colq + bj * 128) = w;
                    if (MODE == 2) {
                        float* dst = nullptr;
                        if (row < MP) { const int s = row & (SEQ - 1); if (s >= SEQ - 128) dst = (bj ? wvp : wkp) + ((size_t)((row >> 14) * 128 + (s - (SEQ - 128))) * 128 + wc * 32 + 8 * fq); }
                        else { const int jj = (row - MP) >> 4, i = row & 15; dst = (bj ? wvs : wks) + ((size_t)(jj * 128 + 112 + i) * 128 + wc * 32 + 8 * fq); }
                        if (dst) { *(pg8::f32x4*)dst = a0; *(pg8::f32x4*)(dst + 4) = a1; }
                    }
                }
            }
    }
};
struct EpiRes {
    bf16* XG; float* ss_acc; float* ss_zero; const float* modl; int ga_off; const float* gsn; const float* gip;
    template <bool UNI> __device__ __forceinline__ void run(const pg8::f32x4 (&acc)[2][2][4][2], const pg8::Unit& u, int wr, int wc, int fr, int fq) const {
        const int rowb = u.pm * 256 + wr * 64 + fr, colb = u.pn * 256 + wc * 32 + 8 * fq;
        pg8::f32x4 gu[2][2], su[2][2], iu[2][2];
        if (UNI) { const float* ga = modl + (size_t)(u.pm >> 6) * NMOD + ga_off + colb; const float* gs = gsn + (size_t)(u.pm >> 6) * DM + colb; const float* gi = gip + (size_t)(u.pm >> 6) * DM + colb;
#pragma unroll
            for (int bj = 0; bj < 2; ++bj) { gu[bj][0] = *(const pg8::f32x4*)(ga + bj * 128); gu[bj][1] = *(const pg8::f32x4*)(ga + bj * 128 + 4); su[bj][0] = *(const pg8::f32x4*)(gs + bj * 128); su[bj][1] = *(const pg8::f32x4*)(gs + bj * 128 + 4);
                iu[bj][0] = *(const pg8::f32x4*)(gi + bj * 128); iu[bj][1] = *(const pg8::f32x4*)(gi + bj * 128 + 4); } }
#pragma unroll
        for (int ai = 0; ai < 2; ++ai)
#pragma unroll
            for (int m = 0; m < 4; ++m) {
                const int row = rowb + ai * 128 + m * 16, b = row_bidx(row);
                const float* ga = modl + (size_t)b * NMOD + ga_off + colb; const float* gs = gsn + (size_t)b * DM + colb; const float* gi = gip + (size_t)b * DM + colb;
                float ssq = 0.f;
#pragma unroll
                for (int bj = 0; bj < 2; ++bj) {
                    bf16* xp = XG + (size_t)row * DM + colb + bj * 128;
                    const u32x4 xw = *(const u32x4*)xp;
                    const pg8::f32x4 g0 = UNI ? gu[bj][0] : *(const pg8::f32x4*)(ga + bj * 128), g1 = UNI ? gu[bj][1] : *(const pg8::f32x4*)(ga + bj * 128 + 4);
                    const pg8::f32x4 s0 = UNI ? su[bj][0] : *(const pg8::f32x4*)(gs + bj * 128), s1 = UNI ? su[bj][1] : *(const pg8::f32x4*)(gs + bj * 128 + 4);
                    const pg8::f32x4 i0 = UNI ? iu[bj][0] : *(const pg8::f32x4*)(gi + bj * 128), i1 = UNI ? iu[bj][1] : *(const pg8::f32x4*)(gi + bj * 128 + 4);
                    pg8::f32x4 x0, x1;
                    x0.x = __uint_as_float(xw.x << 16); x0.y = __uint_as_float(xw.x & 0xffff0000u); x0.z = __uint_as_float(xw.y << 16); x0.w = __uint_as_float(xw.y & 0xffff0000u);
                    x1.x = __uint_as_float(xw.z << 16); x1.y = __uint_as_float(xw.z & 0xffff0000u); x1.z = __uint_as_float(xw.w << 16); x1.w = __uint_as_float(xw.w & 0xffff0000u);
                    x0 = x0 * i0 + g0 * acc[ai][bj][m][0]; x1 = x1 * i1 + g1 * acc[ai][bj][m][1];
                    ssq += ((x0.x * x0.x + x0.y * x0.y) + (x0.z * x0.z + x0.w * x0.w)) + ((x1.x * x1.x + x1.y * x1.y) + (x1.z * x1.z + x1.w * x1.w));
                    x0 = x0 * s0; x1 = x1 * s1;
                    u32x4 w; w.x = pk2(x0.x, x0.y); w.y = pk2(x0.z, x0.w); w.z = pk2(x1.x, x1.y); w.w = pk2(x1.z, x1.w);
                    *(u32x4*)xp = w;
                }
                ssq += __shfl_xor(ssq, 16); ssq += __shfl_xor(ssq, 32);
                if (fq == 0) { atomicAdd(ss_acc + row, ssq); if (u.pn == 0 && wc == 0) ss_zero[row] = 0.f; }
            }
    }
};
struct EpiHid {
    bf16* H; const float* ss; const float* cv;
    template <bool UNI> __device__ __forceinline__ void run(const pg8::f32x4 (&acc)[2][2][4][2], const pg8::Unit& u, int wr, int wc, int fr, int fq) const {
        const int rowb = u.pm * 256 + wr * 64 + fr, colb = u.pn * 256 + wc * 32 + 8 * fq;
        pg8::f32x4 cu[2][2];
        if (UNI) { const float* cb = cv + (size_t)(u.pm >> 6) * DFF + colb;
#pragma unroll
            for (int bj = 0; bj < 2; ++bj) { cu[bj][0] = *(const pg8::f32x4*)(cb + bj * 128); cu[bj][1] = *(const pg8::f32x4*)(cb + bj * 128 + 4); } }
#pragma unroll
        for (int ai = 0; ai < 2; ++ai)
#pragma unroll
            for (int m = 0; m < 4; ++m) {
                const int row = rowb + ai * 128 + m * 16;
                const float rs = row_rstd(ss, row); const float* cb = cv + (size_t)row_bidx(row) * DFF + colb;
                bf16* rp = H + (size_t)row * LDH + colb;
#pragma unroll
                for (int bj = 0; bj < 2; ++bj) {
                    const pg8::f32x4 b0 = UNI ? cu[bj][0] : *(const pg8::f32x4*)(cb + bj * 128), b1 = UNI ? cu[bj][1] : *(const pg8::f32x4*)(cb + bj * 128 + 4);
                    pg8::f32x4 v0 = acc[ai][bj][m][0] * rs + b0, v1 = acc[ai][bj][m][1] * rs + b1;
#pragma unroll
                    for (int j = 0; j < 4; ++j) { const float a = fmaxf(v0[j], 0.f), b = fmaxf(v1[j], 0.f); v0[j] = a * a; v1[j] = b * b; }
                    u32x4 w; w.x = pk2(v0[0], v0[1]); w.y = pk2(v0[2], v0[3]); w.z = pk2(v1[0], v1[1]); w.w = pk2(v1[2], v1[3]);
                    *(u32x4*)(rp + bj * 128) = w;
                }
            }
    }
};
struct EpiCvec {
    float* out; int ld;
    __device__ __forceinline__ void run(const pg8::f32x4 (&acc)[2][2][4][2], const pg8::Unit& u, int wr, int wc, int fr, int fq) const {
        if (wr != 0) return;
        const int colb = u.pn * 256 + wc * 32 + 8 * fq;
#pragma unroll
        for (int m = 0; m < 3; ++m) { const int row = m * 16 + fr;
            if (row < NBT) {
#pragma unroll
                for (int bj = 0; bj < 2; ++bj) { *(pg8::f32x4*)(out + (size_t)row * ld + colb + bj * 128) = acc[0][bj][m][0]; *(pg8::f32x4*)(out + (size_t)row * ld + colb + bj * 128 + 4) = acc[0][bj][m][1]; } } }
    }
};
struct EpiAcc {
    float* Y; int kbytes;
    __device__ __forceinline__ void run(const pg8::f32x4 (&acc)[2][2][4][2], const pg8::Unit& u, int wr, int wc, int fr, int fq) const {
        const int rowb = u.pm * 256 - MP + wr * 64 + fr, colb = u.pn * 256 + wc * 32 + 8 * fq;
        float* Ys = Y + (size_t)(u.koff / kbytes) * MS * DM;
#pragma unroll
        for (int ai = 0; ai < 2; ++ai)
#pragma unroll
            for (int m = 0; m < 4; ++m) { float* yp = Ys + (size_t)(rowb + ai * 128 + m * 16) * DM + colb;
#pragma unroll
                for (int bj = 0; bj < 2; ++bj) { *(pg8::f32x4*)(yp + bj * 128) = acc[ai][bj][m][0]; *(pg8::f32x4*)(yp + bj * 128 + 4) = acc[ai][bj][m][1]; } }
    }
};
struct EpiAll {
    static constexpr bool AFTER_DRAIN = false;
    int kind, l; unsigned char* ws; float* out;
    __device__ __forceinline__ bool perm() const { return true; }
    __device__ __forceinline__ void operator()(const pg8::f32x4 (&acc)[2][2][4][2], const pg8::Unit& u, int wr, int wc, int fr, int fq) const {
        const bool uni = u.pm < MP / 256;
        float* const ssa = (float*)(ws + WS_SSP); float* const ssb = ssa + MT;
        if (kind == 0) {
            const EpiG1 e{(bf16*)(ws + WS_U), (const float*)(ws + WS_CS), out + O_WKP + (size_t)l * 32768, out + O_WVP + (size_t)l * 32768, out + O_WKS + (size_t)l * 524288, out + O_WVS + (size_t)l * 524288, ssb, (const float*)(ws + WS_C1) + (size_t)l * NBT * INW};
            if (uni) e.run<true>(acc, u, wr, wc, fr, fq); else e.run<false>(acc, u, wr, wc, fr, fq);
        } else if (kind == 1) {
            const EpiHid e{(bf16*)(ws + WS_HID), ssa, (const float*)(ws + WS_C2) + (size_t)l * NBT * DFF};
            if (uni) e.run<true>(acc, u, wr, wc, fr, fq); else e.run<false>(acc, u, wr, wc, fr, fq);
        } else if (kind == 2 || kind == 3) {
            const bool o = kind == 2;
            const EpiRes e{(bf16*)(ws + WS_XG), o ? ssa : ssb, o ? ssb : ssa, (const float*)(ws + WS_MOD) + (size_t)l * NBT * NMOD, (o ? 2 : 5) * DM, (const float*)(ws + WS_GS) + (size_t)(o ? 2 * l + 1 : 2 * l + 2) * NBT * DM, (const float*)(ws + WS_GSI) + (size_t)(o ? 2 * l : 2 * l + 1) * NBT * DM};
            if (uni) e.run<true>(acc, u, wr, wc, fr, fq); else e.run<false>(acc, u, wr, wc, fr, fq);
        } else if (kind == 5 || kind == 6) {
            const EpiAcc e{(float*)(ws + (kind == 5 ? WS_Y2 : WS_Y4)), kind == 5 ? 2 * DM / KS2 : 2 * DFF / KS4};
            e.run(acc, u, wr, wc, fr, fq);
        } else {
            const int sl = l >> 1; const bool cup = (l & 1) != 0;
            const EpiCvec e{cup ? (float*)(ws + WS_C2) + (size_t)sl * NBT * DFF : (float*)(ws + WS_C1) + (size_t)sl * NBT * INW, cup ? DFF : INW};
            e.run(acc, u, wr, wc, fr, fq);
        }
    }
};

struct Params { const float* in[18]; float* out; unsigned char* ws; int ph_lo, ph_hi, coop, pad; };
struct Ctx { LAS unsigned char* lds; int tid, lane, wave, vcu, G; };
#define LDS_WAIT() asm volatile("s_waitcnt lgkmcnt(0)" ::: "memory")

__device__ __constant__ const double INVF[64] = {1.0, 0.8659643233600653, 0.7498942093324559, 0.6493816315762113, 0.5623413251903491, 0.4869675251658631, 0.4216965034285822, 0.3651741272548377, 0.31622776601683794, 0.27384196342643613, 0.23713737056616552, 0.2053525026457146, 0.1778279410038923, 0.1539926526059492, 0.1333521432163324, 0.11547819846894582, 0.1, 0.08659643233600653, 0.07498942093324558, 0.06493816315762113, 0.05623413251903491, 0.04869675251658631, 0.042169650342858224, 0.03651741272548377, 0.03162277660168379, 0.027384196342643614, 0.023713737056616554, 0.02053525026457146, 0.01778279410038923, 0.01539926526059492, 0.01333521432163324, 0.011547819846894581, 0.01, 0.008659643233600654, 0.007498942093324558, 0.006493816315762113, 0.005623413251903491, 0.004869675251658631, 0.004216965034285823, 0.003651741272548377, 0.0031622776601683794, 0.0027384196342643613, 0.0023713737056616554, 0.002053525026457146, 0.0017782794100389228, 0.001539926526059492, 0.001333521432163324, 0.0011547819846894581, 0.001, 0.0008659643233600654, 0.0007498942093324559, 0.0006493816315762113, 0.0005623413251903491, 0.0004869675251658631, 0.00042169650342858224, 0.0003651741272548377, 0.00031622776601683794, 0.0002738419634264361, 0.00023713737056616554, 0.0002053525026457146, 0.00017782794100389227, 0.0001539926526059492, 0.0001333521432163324, 0.00011547819846894582};

template <bool ROT> __device__ __forceinline__ void p0_transpose_item(const float* W, int K, int N, bf16* WT, int ldo, LAS float* scr, int item, int lane) {
    const int nblk = N / 32, kb = item / nblk, nb = item % nblk, k0 = 64 * kb, n0 = 32 * nb;
#pragma unroll 8
    for (int i = 0; i < 32; ++i) { const int kk = 2 * i + (lane >> 5); scr[kk * 33 + (lane & 31)] = W[(size_t)(k0 + kk) * N + n0 + (lane & 31)]; }
    LDS_WAIT(); asm volatile("" ::: "memory");
    const int c = lane & 7;
#pragma unroll
    for (int j = 0; j < 4; ++j) { const int n = (lane >> 3) + 8 * j; const LAS float* s = scr + (8 * c) * 33 + n;
        u32x4 o; o.x = pk2(s[0 * 33], s[1 * 33]); o.y = pk2(s[2 * 33], s[3 * 33]); o.z = pk2(s[4 * 33], s[5 * 33]); o.w = pk2(s[6 * 33], s[7 * 33]);
        int nd = n0 + n;
        if (ROT && nd >= 768 && nd < 1792) { const int d = nd & 127; nd = (nd & ~127) + 8 * ((d & 63) >> 2) + 4 * (d >> 6) + (d & 3); }
        *(u32x4*)(WT + (size_t)nd * ldo + k0 + 8 * c) = o; }
    LDS_WAIT(); asm volatile("" ::: "memory");
}

constexpr int ADA_TROW = 2064, ADA_TLO = NBT * ADA_TROW;
static_assert(2 * ADA_TLO <= MISC_OFF, "adaLN LDS map");
__device__ __forceinline__ void ada_item(const Ctx& C, const float* W, int eg, const float* bias, float* out, bf16* shm) {
    LAS unsigned char* lds = C.lds;
    const int w = C.wave, l31 = C.lane & 31, h = C.lane >> 5;
    f32x16 acc[2][2];
#pragma unroll
    for (int mt = 0; mt < 2; ++mt)
#pragma unroll
        for (int nt = 0; nt < 2; ++nt)
#pragma unroll
            for (int r = 0; r < 16; ++r) acc[mt][nt][r] = 0.f;
    const float* wp = W + (size_t)(128 * w + 8 * h) * NMOD + eg * 64 + l31;
    const int ra0 = l31 * ADA_TROW, ra1 = ((32 + l31) < NBT ? (32 + l31) : NBT - 1) * ADA_TROW;
#pragma unroll 1
    for (int hf = 0; hf < 2; ++hf) {
        float wv[4][2][8];
#pragma unroll
        for (int s = 0; s < 4; ++s)
#pragma unroll
            for (int nt = 0; nt < 2; ++nt)
#pragma unroll
                for (int j = 0; j < 8; ++j) wv[s][nt][j] = wp[(size_t)(64 * hf + 16 * s + j) * NMOD + 32 * nt];
#pragma unroll
        for (int s = 0; s < 4; ++s) {
            const int kb = (128 * w + 64 * hf + 16 * s + 8 * h) * 2;
            bf16x8 ah[2], al[2], bh[2], bl[2];
            ah[0] = *(const LAS bf16x8*)(lds + ra0 + kb); al[0] = *(const LAS bf16x8*)(lds + ADA_TLO + ra0 + kb);
            ah[1] = *(const LAS bf16x8*)(lds + ra1 + kb); al[1] = *(const LAS bf16x8*)(lds + ADA_TLO + ra1 + kb);
#pragma unroll
            for (int nt = 0; nt < 2; ++nt) { u32x4 ph, pl;
                unsigned* phw = (unsigned*)&ph; unsigned* plw = (unsigned*)&pl;
#pragma unroll
                for (int jj = 0; jj < 4; ++jj) { const float a = wv[s][nt][2 * jj], bq = wv[s][nt][2 * jj + 1]; const unsigned hh = pk2(a, bq);
                    phw[jj] = hh; plw[jj] = pk2(a - __uint_as_float(hh << 16), bq - __uint_as_float(hh & 0xffff0000u)); }
                bh[nt] = __builtin_bit_cast(bf16x8, ph); bl[nt] = __builtin_bit_cast(bf16x8, pl); }
#pragma unroll
            for (int mt = 0; mt < 2; ++mt)
#pragma unroll
                for (int nt = 0; nt < 2; ++nt) { acc[mt][nt] = MFMA32(ah[mt], bh[nt], acc[mt][nt]); acc[mt][nt] = MFMA32(ah[mt], bl[nt], acc[mt][nt]); acc[mt][nt] = MFMA32(al[mt], bh[nt], acc[mt][nt]); }
        }
    }
    __syncthreads();
    LAS float* red = (LAS float*)lds;
#pragma unroll
    for (int mt = 0; mt < 2; ++mt)
#pragma unroll
        for (int nt = 0; nt < 2; ++nt)
#pragma unroll
            for (int r = 0; r < 16; ++r) { const int b = 32 * mt + crow(r, h); if (b < NBT) red[(w * NBT + b) * 64 + 32 * nt + l31] = acc[mt][nt][r]; }
    __syncthreads();
    for (int o = C.tid; o < NBT * 64; o += 512) { const int b = o >> 6, ln = o & 63; float s = bias[eg * 64 + ln];
#pragma unroll
        for (int ww = 0; ww < 8; ++ww) s += red[(ww * NBT + b) * 64 + ln];
        const int nd = eg * 64 + ln;
        out[(size_t)b * NMOD + nd] = s;
        const int kind = nd < DM ? 0 : ((nd >= 3 * DM && nd < 4 * DM) ? 1 : -1);
        if (kind >= 0) shm[((size_t)kind * 256 + b) * DM + (nd & (DM - 1))] = (bf16)(pk2(s, 0.f) & 0xffff); }
    __syncthreads();
}

__device__ __forceinline__ void phase_prologue(const Ctx& C, const Params& P) {
    unsigned char* ws = P.ws;
    if (P.pad & 1) {
        LAS float* scr = (LAS float*)(C.lds + C.wave * 16384);
        const int gw = C.vcu * 8 + C.wave, NGW = C.G * 8;
        constexpr int I_IN = (DM / 64) * (INW / 32), I_O = (DM / 64) * (DM / 32), I_U = (DM / 64) * (DFF / 32), I_D = (DFF / 64) * (DM / 32), I_L = I_IN + I_O + I_U + I_D;
        constexpr int I_S = NLAYER * DBS * 4 * 8;
        for (int it = gw; it < NLAYER * I_L + I_S; it += NGW) {
            if (it < NLAYER * I_L) {
                const int l = it / I_L; int r = it % I_L;
                if (r < I_IN) { p0_transpose_item<true>(P.in[I_WIN] + (size_t)l * DM * INW, DM, INW, (bf16*)(ws + WS_WIN) + (size_t)l * INW * DM, DM, scr, r, C.lane); continue; } r -= I_IN;
                if (r < I_O) { p0_transpose_item<false>(P.in[I_WOUT] + (size_t)l * DM * DM, DM, DM, (bf16*)(ws + WS_WOUT) + (size_t)l * DM * DM, DM, scr, r, C.lane); continue; } r -= I_O;
                if (r < I_U) { p0_transpose_item<false>(P.in[I_WUP] + (size_t)l * DM * DFF, DM, DFF, (bf16*)(ws + WS_WUP) + (size_t)l * DFF * DM, DM, scr, r, C.lane); continue; } r -= I_U;
                p0_transpose_item<false>(P.in[I_WDN] + (size_t)l * DFF * DM, DFF, DM, (bf16*)(ws + WS_WDN) + (size_t)l * DM * LDH, LDH, scr, r, C.lane);
            } else {
                const int r = it - NLAYER * I_L, mtx = r >> 3;
                p0_transpose_item<false>(P.in[I_SR] + (size_t)mtx * 16384, 128, 128, (bf16*)(ws + WS_SS0) + (size_t)mtx * 16384, 128, scr, r & 7, C.lane);
            }
        }
    }
    if (P.pad & 2) {
        float* cs = (float*)(ws + WS_CS);
        for (int i = C.vcu * 512 + C.tid; i < CS_ROWS * 64; i += C.G * 512) {
            const int r = i >> 6, d = i & 63; const int pos = r < SEQ ? r : 4096 + (r - SEQ);
            const double rev = (double)pos * INVF[d] * 0.15915494309189535; const float fr = (float)(rev - __builtin_rint(rev));
            f32x2 o; o.x = __builtin_amdgcn_cosf(fr); o.y = __builtin_amdgcn_sinf(fr);
            *(f32x2*)(cs + (size_t)i * 2) = o;
        }
    }
    for (int i = C.vcu * 512 + C.tid; i < 2048; i += C.G * 512) { const int idx = i & 255, hg = i >> 8;
        ((float*)(ws + WS_BT))[i] = idx < 255 ? P.in[I_RELB][rel_bucket(idx - 191) * 8 + hg] * LOG2E : 0.f; }
    {
        constexpr int NV = NLAYER * DBS * 112 * 32;
        for (int i = C.vcu * 512 + C.tid; i < 2 * NV; i += C.G * 512) {
            const int t = i >= NV, q = t ? i - NV : i; const int lj = q / (112 * 32), rem = q % (112 * 32);
            const f32x4 v = *(const f32x4*)(P.in[t ? I_CV : I_CK] + (size_t)lj * 16384 + 16 * 128 + (size_t)rem * 4);
            *(f32x4*)(P.out + (t ? O_WVS : O_WKS) + (size_t)lj * 16384 + (size_t)rem * 4) = v;
        }
    }
    __syncthreads();
    if (P.pad & 4) for (int it = C.vcu; it < NLAYER * (NMOD / 64); it += C.G) {
        const int l = it / (NMOD / 64), eg = it % (NMOD / 64);
        for (int i = C.tid; i < NBT * DM / 2; i += 512) { const int b = i >> 9, k = (i & 511) * 2;
            const f32x2 c = *(const f32x2*)(b < NBP ? P.in[I_CP] + b * DM + k : P.in[I_CS] + (b - NBP) * DM + k);
            const float s0 = c.x / (1.f + __expf(-c.x)), s1 = c.y / (1.f + __expf(-c.y)); const unsigned hh = pk2(s0, s1);
            *(LAS unsigned*)(C.lds + b * ADA_TROW + k * 2) = hh;
            *(LAS unsigned*)(C.lds + ADA_TLO + b * ADA_TROW + k * 2) = pk2(s0 - __uint_as_float(hh << 16), s1 - __uint_as_float(hh & 0xffff0000u)); }
        __syncthreads();
        ada_item(C, P.in[I_WADA] + (size_t)l * DM * NMOD, eg, P.in[I_BADA] + (size_t)l * NMOD, (float*)(ws + WS_MOD) + (size_t)l * NBT * NMOD, (bf16*)(ws + WS_SHM) + (size_t)l * 2 * 256 * DM);
    }
}
constexpr int NCVEC = INW / 256;
__device__ __forceinline__ void phase_prologue2(const Ctx& C, const Params& P) {
    unsigned char* ws = P.ws;
    const float* mod = (const float*)(ws + WS_MOD);
    {
        float* GS = (float*)(ws + WS_GS);
        for (int i = C.vcu * 512 + C.tid; i < (NLAYER * 2 + 1) * NBT * DM; i += C.G * 512) {
            const int c = i & (DM - 1), b = (i >> 10) % NBT, lk = i / (NBT * DM);
            float v;
            if (lk == NLAYER * 2) v = P.in[I_GFIN][c];
            else { const int l = lk >> 1, kind = lk & 1; v = P.in[kind ? I_GMLP : I_GMIX][l * DM + c] * (1.0f + mod[((size_t)l * NBT + b) * NMOD + (kind ? 4 : 1) * DM + c]); }
            GS[i] = v;
            if (lk < NLAYER * 2) ((float*)(ws + WS_GSI))[i] = 1.0f / v;
        }
    }
    {
        const int bx = blockIdx.x, G = C.G, ncv = G > NCVEC ? NCVEC : 0;
        const long tot = ncv + 3L * (G - ncv);
        const long p0 = bx < ncv ? bx : ncv + 3L * (bx - ncv), p1 = (bx + 1) <= ncv ? (bx + 1) : ncv + 3L * (bx + 1 - ncv);
        const int r0 = (int)((long)MT * p0 / tot), r1 = (int)((long)MT * p1 / tot);
        bf16* XG = (bf16*)(ws + WS_XG); bf16* XB = (bf16*)(ws + WS_XB) - (size_t)MP * DM;   float* ssa = (float*)(ws + WS_SSP); float* ssb = ssa + MT;
        for (int r = r0 + C.wave; r < r1; r += 8) {
            const float* xr = r < MP ? P.in[I_XP] + (size_t)r * DM : P.in[I_XS] + (size_t)(r - MP) * DM;
            const float* sc = mod + (size_t)row_bidx(r) * NMOD + DM;
            float s = 0.f;
#pragma unroll
            for (int j = 0; j < 4; ++j) { const int c = 4 * C.lane + 256 * j; const f32x4 v = *(const f32x4*)(xr + c); s += (v.x * v.x + v.y * v.y) + (v.z * v.z + v.w * v.w);
                const f32x4 gv = *(const f32x4*)(P.in[I_GMIX] + c), sv = *(const f32x4*)(sc + c); const f32x4 h = v * gv * (sv + 1.0f);
                u32x2 w; w.x = pk2(h.x, h.y); w.y = pk2(h.z, h.w); *(u32x2*)(XG + (size_t)r * DM + c) = w;
                if (r >= MP) { w.x = pk2(v.x, v.y); w.y = pk2(v.z, v.w); *(u32x2*)(XB + (size_t)r * DM + c) = w; } }
            s = wave_sum(s);
            if (C.lane == 0) { ssb[r] = s; ssa[r] = 0.f; }
        }
    }
}

__device__ __forceinline__ void phase_final(const Ctx& C, const bf16* XG, const float* ss, float* y) {
    const int gw = C.vcu * 8 + C.wave, NGW = C.G * 8;
    for (int r = gw; r < MT; r += NGW) {
        const float rs = row_rstd(ss, r);
#pragma unroll
        for (int j = 0; j < 2; ++j) { const int c = 8 * C.lane + 512 * j;
            const u32x4 xw = *(const u32x4*)(XG + (size_t)r * DM + c);
            f32x4 x0, x1;
            x0.x = __uint_as_float(xw.x << 16); x0.y = __uint_as_float(xw.x & 0xffff0000u); x0.z = __uint_as_float(xw.y << 16); x0.w = __uint_as_float(xw.y & 0xffff0000u);
            x1.x = __uint_as_float(xw.z << 16); x1.y = __uint_as_float(xw.z & 0xffff0000u); x1.z = __uint_as_float(xw.w << 16); x1.w = __uint_as_float(xw.w & 0xffff0000u);
            *(f32x4*)(y + (size_t)r * DM + c) = x0 * rs; *(f32x4*)(y + (size_t)r * DM + c + 4) = x1 * rs; }
    }
}
template <int KS> __device__ __forceinline__ void phase_fz(const Ctx& C, bf16* XB, bf16* XG, const float* Y, float* ss, const float* modl, int ga_off, const float* gsn) {
    const int gw = C.vcu * 8 + C.wave, NGW = C.G * 8;
    for (int rr = gw; rr < MS; rr += NGW) {
        const int r = MP + rr, b = row_bidx(r); float s = 0.f;
#pragma unroll
        for (int j = 0; j < 2; ++j) { const int c = 8 * C.lane + 512 * j;
            const u32x4 xw = *(const u32x4*)(XB + (size_t)r * DM + c);
            f32x4 y0 = {0.f, 0.f, 0.f, 0.f}, y1 = {0.f, 0.f, 0.f, 0.f};
#pragma unroll
            for (int q = 0; q < KS; ++q) { const f32x4* yp = (const f32x4*)(Y + ((size_t)q * MS + rr) * DM + c); y0 = y0 + yp[0]; y1 = y1 + yp[1]; }
            const float* ga = modl + (size_t)b * NMOD + ga_off + c; const float* gs = gsn + (size_t)b * DM + c;
            const f32x4 g0 = *(const f32x4*)ga, g1 = *(const f32x4*)(ga + 4), s0 = *(const f32x4*)gs, s1 = *(const f32x4*)(gs + 4);
            f32x4 x0, x1;
            x0.x = __uint_as_float(xw.x << 16); x0.y = __uint_as_float(xw.x & 0xffff0000u); x0.z = __uint_as_float(xw.y << 16); x0.w = __uint_as_float(xw.y & 0xffff0000u);
            x1.x = __uint_as_float(xw.z << 16); x1.y = __uint_as_float(xw.z & 0xffff0000u); x1.z = __uint_as_float(xw.w << 16); x1.w = __uint_as_float(xw.w & 0xffff0000u);
            x0 = x0 + g0 * y0; x1 = x1 + g1 * y1;
            s += ((x0.x * x0.x + x0.y * x0.y) + (x0.z * x0.z + x0.w * x0.w)) + ((x1.x * x1.x + x1.y * x1.y) + (x1.z * x1.z + x1.w * x1.w));
            u32x4 w; w.x = pk2(x0.x, x0.y); w.y = pk2(x0.z, x0.w); w.z = pk2(x1.x, x1.y); w.w = pk2(x1.z, x1.w);
            *(u32x4*)(XB + (size_t)r * DM + c) = w;
            x0 = x0 * s0; x1 = x1 * s1;
            w.x = pk2(x0.x, x0.y); w.y = pk2(x0.z, x0.w); w.z = pk2(x1.x, x1.y); w.w = pk2(x1.z, x1.w);
            *(u32x4*)(XG + (size_t)r * DM + c) = w; }
        s = wave_sum(s);
        if (C.lane == 0) ss[r] = s;
    }
}

constexpr int AT_K = 0, AT_KROW = 144, AT_V = 192 * AT_KROW, AT_B = AT_V + 192 * 128, AT_END = AT_B + 4 * 256 * 4;
static_assert(AT_B % 16 == 0 && AT_END <= LDS_BYTES, "attention LDS map");
__device__ __forceinline__ unsigned off64(unsigned row, unsigned ch) { return 1024u * (row >> 3) + 512u * (ch >> 2) + 64u * (row & 7) + 16u * ((ch & 3) ^ ((row >> 2) & 3)); }
__device__ __forceinline__ void tr_read4(unsigned b0, unsigned b1, bf16x8 (&a)[2]) {
    s16x4 l0, l1, h0, h1;
    asm volatile("ds_read_b64_tr_b16 %0, %4\n\tds_read_b64_tr_b16 %1, %4 offset:512\n\tds_read_b64_tr_b16 %2, %5\n\tds_read_b64_tr_b16 %3, %5 offset:512\n\ts_waitcnt lgkmcnt(0)"
                 : "=&v"(l0), "=&v"(l1), "=&v"(h0), "=&v"(h1) : "v"(b0), "v"(b1) : "memory");
    a[0] = __builtin_shufflevector(l0, h0, 0, 1, 2, 3, 4, 5, 6, 7); a[1] = __builtin_shufflevector(l1, h1, 0, 1, 2, 3, 4, 5, 6, 7);
}
template <bool SAMPLE> __device__ __forceinline__ void att_unit(const Ctx& C, const bf16* U, bf16* MIX, const float* sinks, const float* btab  , const float* ck, const float* cv, int b, int c, int kvh) {
    LAS unsigned char* lds = C.lds;
    constexpr int NT = SAMPLE ? 5 : 6, NK = SAMPLE ? 144 : 192;
    const int rowq0 = SAMPLE ? MP + 16 * b : b * SEQ + 64 * c;
    if (C.tid < 256) *(LAS f32x4*)(lds + AT_B + 16 * C.tid) = *(const f32x4*)(btab + kvh * 1024 + 4 * C.tid);
    for (int ci = C.tid; ci < NT * 32 * 8; ci += 512) {
        const int jb = ci >> 3, ch = ci & 7;
        u32x4 kv = {0u, 0u, 0u, 0u}, vv = {0u, 0u, 0u, 0u};
        if (SAMPLE) {
            if (jb < 128) { const float* kp = ck + ((size_t)(b * 128 + jb) * 2 + kvh) * 64 + 8 * ch; const float* vp = cv + ((size_t)(b * 128 + jb) * 2 + kvh) * 64 + 8 * ch;
                const f32x4 k0 = *(const f32x4*)kp, k1 = *(const f32x4*)(kp + 4), v0 = *(const f32x4*)vp, v1 = *(const f32x4*)(vp + 4);
                kv.x = pk2(k0.x, k0.y); kv.y = pk2(k0.z, k0.w); kv.z = pk2(k1.x, k1.y); kv.w = pk2(k1.z, k1.w);
                vv.x = pk2(v0.x, v0.y); vv.y = pk2(v0.z, v0.w); vv.z = pk2(v1.x, v1.y); vv.w = pk2(v1.z, v1.w); }
            else if (jb < NK) { const bf16* rp = U + (size_t)(rowq0 + jb - 128) * INW + 512 + kvh * 64 + 8 * ch; kv = *(const u32x4*)rp; vv = *(const u32x4*)(rp + 128); }
        } else {
            const int s = 64 * (c - 2) + jb;
            if (s >= 0) { const bf16* rp = U + (size_t)(b * SEQ + s) * INW + 512 + kvh * 64 + 8 * ch; kv = *(const u32x4*)rp; vv = *(const u32x4*)(rp + 128); }
        }
        *(LAS u32x4*)(lds + AT_K + jb * AT_KROW + 16 * ch) = kv;
        *(LAS u32x4*)(lds + AT_V + off64(jb, ch)) = vv;
    }
    __syncthreads();
    const int w = C.wave, l31 = C.lane & 31, h = C.lane >> 5;
    if (!SAMPLE || w < 4) {
        const int g = SAMPLE ? w : (w >> 1), qi = SAMPLE ? l31 : 32 * (w & 1) + l31, head = kvh * 4 + g;
        const int qrow = rowq0 + (SAMPLE ? (qi < 16 ? qi : 15) : qi);
        const int t0 = SAMPLE ? 0 : (c == 0 ? 4 : (c == 1 ? 2 : 0));
        bf16x8 bq[4];
#pragma unroll
        for (int s = 0; s < 4; ++s) bq[s] = *(const bf16x8*)(U + (size_t)qrow * INW + head * 64 + 16 * s + 8 * h);
        f32x16 S[NT];
#pragma unroll
        for (int t = 0; t < NT; ++t) {
#pragma unroll
            for (int r = 0; r < 16; ++r) S[t][r] = 0.f;
            if (t >= t0) {
#pragma unroll
                for (int s = 0; s < 4; ++s) { const bf16x8 a = *(const LAS bf16x8*)(lds + AT_K + (32 * t + l31) * AT_KROW + (16 * s + 8 * h) * 2); S[t] = MFMA32(a, bq[s], S[t]); }
            }
        }
        const float sink2 = sinks[head] * LOG2E;
        const LAS float* bt = (const LAS float*)(lds + AT_B) + g * 256 + 63 - qi;
        float m = sink2;
#pragma unroll
        for (int t = 0; t < NT; ++t) if (t >= t0) {
#pragma unroll
            for (int r = 0; r < 16; ++r) { const int key = 32 * t + crow(r, h); float v = S[t][r] + bt[key]; if (SAMPLE && key >= NK) v = -1e30f; S[t][r] = v; m = fmaxf(m, v); }
        }
        m = fmaxf(m, __shfl_xor(m, 32));
        float lsum = 0.f;
#pragma unroll
        for (int t = 0; t < NT; ++t) if (t >= t0) {
#pragma unroll
            for (int r = 0; r < 16; ++r) { const float p = __builtin_amdgcn_exp2f(S[t][r] - m); S[t][r] = p; lsum += p; }
        }
        lsum += __shfl_xor(lsum, 32);
        lsum += __builtin_amdgcn_exp2f(sink2 - m);
        f32x16 O[2];
#pragma unroll
        for (int et = 0; et < 2; ++et)
#pragma unroll
            for (int r = 0; r < 16; ++r) O[et][r] = 0.f;
        const unsigned blk = (C.lane >> 4) & 1, q4 = (C.lane & 15) >> 2, p4 = C.lane & 3;
        const unsigned vb0 = (unsigned)(size_t)(lds + AT_V) + 64u * (4u * h + q4) + 16u * ((2u * blk + (p4 >> 1)) ^ (unsigned)h) + 8u * (p4 & 1);
        const unsigned vb1 = (unsigned)(size_t)(lds + AT_V) + 64u * (4u * h + q4) + 16u * ((2u * blk + (p4 >> 1)) ^ (2u + (unsigned)h)) + 8u * (p4 & 1) + 1024u;
#pragma unroll
        for (int t = 0; t < NT; ++t) if (t >= t0) {
#pragma unroll
            for (int sp = 0; sp < 2; ++sp) {
                u32x4 pw; pw.x = pk2(S[t][8 * sp + 0], S[t][8 * sp + 1]); pw.y = pk2(S[t][8 * sp + 2], S[t][8 * sp + 3]); pw.z = pk2(S[t][8 * sp + 4], S[t][8 * sp + 5]); pw.w = pk2(S[t][8 * sp + 6], S[t][8 * sp + 7]);
                const bf16x8 pb = __builtin_bit_cast(bf16x8, pw);
                bf16x8 av[2];
                tr_read4(vb0 + 1024u * (4 * t + 2 * sp), vb1 + 1024u * (4 * t + 2 * sp), av);
                __builtin_amdgcn_sched_barrier(0);
                O[0] = MFMA32(av[0], pb, O[0]); O[1] = MFMA32(av[1], pb, O[1]);
            }
        }
        const float inv = __builtin_amdgcn_rcpf(lsum);
        if (!SAMPLE || qi < 16) {
            bf16* op = MIX + (size_t)qrow * DM + head * 64;
#pragma unroll
            for (int et = 0; et < 2; ++et)
#pragma unroll
                for (int rg = 0; rg < 4; ++rg) { u32x2 wv; wv.x = pk2(O[et][4 * rg] * inv, O[et][4 * rg + 1] * inv); wv.y = pk2(O[et][4 * rg + 2] * inv, O[et][4 * rg + 3] * inv);
                    *(u32x2*)(op + 32 * et + 8 * rg + 4 * h) = wv; }
        }
    }
    __syncthreads();
}

constexpr int AS_K = 0, AS_V = 384 * AT_KROW, AS_B = AS_V + 384 * 128, AS_END = AS_B + 4 * 256 * 4;
static_assert(AS_V % 16 == 0 && AS_B % 16 == 0 && AS_END <= MISC_OFF, "attention (4-chunk) LDS map");
__device__ __forceinline__ void att_super(const Ctx& C, const bf16* U, bf16* MIX, const float* sinks, const float* btab  , int b, int kvh, int c0) {
    LAS unsigned char* lds = C.lds;
    if (C.tid < 256) *(LAS f32x4*)(lds + AS_B + 16 * C.tid) = *(const f32x4*)(btab + kvh * 1024 + 4 * C.tid);
    for (int ci = C.tid; ci < 384 * 8; ci += 512) {
        const int jl = ci >> 3, ch = ci & 7;
        u32x4 kv = {0u, 0u, 0u, 0u}, vv = {0u, 0u, 0u, 0u};
        const int s = 64 * (c0 - 2) + jl;
        if (s >= 0) { const bf16* rp = U + (size_t)(b * SEQ + s) * INW + 512 + kvh * 64 + 8 * ch; kv = *(const u32x4*)rp; vv = *(const u32x4*)(rp + 128); }
        *(LAS u32x4*)(lds + AS_K + jl * AT_KROW + 16 * ch) = kv;
        *(LAS u32x4*)(lds + AS_V + off64(jl, ch)) = vv;
    }
    const int w = C.wave, l31 = C.lane & 31, h = C.lane >> 5;
    const int g = w >> 1, qi = 32 * (w & 1) + l31, head = kvh * 4 + g;
    const float sink2 = sinks[head] * LOG2E;
    bf16x8 bq[4];
#pragma unroll
    for (int s = 0; s < 4; ++s) bq[s] = *(const bf16x8*)(U + (size_t)(b * SEQ + 64 * c0 + qi) * INW + head * 64 + 16 * s + 8 * h);
    __syncthreads();
    const LAS float* bt = (const LAS float*)(lds + AS_B) + g * 256 + 63 - qi;
    const unsigned blk = (C.lane >> 4) & 1, q4 = (C.lane & 15) >> 2, p4 = C.lane & 3;
    const unsigned vb0 = (unsigned)(size_t)(lds + AS_V) + 64u * (4u * h + q4) + 16u * ((2u * blk + (p4 >> 1)) ^ (unsigned)h) + 8u * (p4 & 1);
    const unsigned vb1 = (unsigned)(size_t)(lds + AS_V) + 64u * (4u * h + q4) + 16u * ((2u * blk + (p4 >> 1)) ^ (2u + (unsigned)h)) + 8u * (p4 & 1) + 1024u;
#pragma unroll 1
    for (int q = 0; q < 4; ++q) {
        const int c = c0 + q, qrow = b * SEQ + 64 * c + qi;
        const int t0 = c == 0 ? 4 : (c == 1 ? 2 : 0);
        bf16x8 bqn[4];
        { const int qn = q < 3 ? q + 1 : 3;
#pragma unroll
          for (int s = 0; s < 4; ++s) bqn[s] = *(const bf16x8*)(U + (size_t)(b * SEQ + 64 * (c0 + qn) + qi) * INW + head * 64 + 16 * s + 8 * h); }
        f32x16 S[6];
#pragma unroll
        for (int t = 0; t < 6; ++t) {
#pragma unroll
            for (int r = 0; r < 16; ++r) S[t][r] = 0.f;
            if (t >= t0) {
#pragma unroll
                for (int s = 0; s < 4; ++s) { const bf16x8 a = *(const LAS bf16x8*)(lds + AS_K + (64 * q + 32 * t + l31) * AT_KROW + (16 * s + 8 * h) * 2); S[t] = MFMA32(a, bq[s], S[t]); }
            }
        }
        float m = sink2;
#pragma unroll
        for (int t = 0; t < 6; ++t) if (t >= t0) {
#pragma unroll
            for (int r = 0; r < 16; ++r) { const float v = S[t][r] + bt[32 * t + crow(r, h)]; S[t][r] = v; m = fmaxf(m, v); }
        }
        m = fmaxf(m, __shfl_xor(m, 32));
        float lsum = 0.f;
#pragma unroll
        for (int t = 0; t < 6; ++t) if (t >= t0) {
#pragma unroll
            for (int r = 0; r < 16; ++r) { const float p = __builtin_amdgcn_exp2f(S[t][r] - m); S[t][r] = p; lsum += p; }
        }
        lsum += __shfl_xor(lsum, 32);
        lsum += __builtin_amdgcn_exp2f(sink2 - m);
        f32x16 O[2];
#pragma unroll
        for (int et = 0; et < 2; ++et)
#pragma unroll
            for (int r = 0; r < 16; ++r) O[et][r] = 0.f;
#pragma unroll
        for (int t = 0; t < 6; ++t) if (t >= t0) {
#pragma unroll
            for (int sp = 0; sp < 2; ++sp) {
                u32x4 pw; pw.x = pk2(S[t][8 * sp + 0], S[t][8 * sp + 1]); pw.y = pk2(S[t][8 * sp + 2], S[t][8 * sp + 3]); pw.z = pk2(S[t][8 * sp + 4], S[t][8 * sp + 5]); pw.w = pk2(S[t][8 * sp + 6], S[t][8 * sp + 7]);
                const bf16x8 pb = __builtin_bit_cast(bf16x8, pw);
                bf16x8 av[2];
                const unsigned ko = 1024u * (unsigned)(8 * q + 4 * t + 2 * sp);
                tr_read4(vb0 + ko, vb1 + ko, av);
                __builtin_amdgcn_sched_barrier(0);
                O[0] = MFMA32(av[0], pb, O[0]); O[1] = MFMA32(av[1], pb, O[1]);
            }
        }
        const float inv = __builtin_amdgcn_rcpf(lsum);
        bf16* op = MIX + (size_t)qrow * DM + head * 64;
#pragma unroll
        for (int et = 0; et < 2; ++et)
#pragma unroll
            for (int rp = 0; rp < 2; ++rp) {
                const unsigned ax = pk2(O[et][8 * rp] * inv, O[et][8 * rp + 1] * inv), ay = pk2(O[et][8 * rp + 2] * inv, O[et][8 * rp + 3] * inv);
                const unsigned bx = pk2(O[et][8 * rp + 4] * inv, O[et][8 * rp + 5] * inv), by = pk2(O[et][8 * rp + 6] * inv, O[et][8 * rp + 7] * inv);
                const auto r0 = __builtin_amdgcn_permlane32_swap(ax, bx, false, false), r1 = __builtin_amdgcn_permlane32_swap(ay, by, false, false);
                u32x4 wv; wv.x = r0[0]; wv.y = r1[0]; wv.z = r0[1]; wv.w = r1[1];
                *(u32x4*)(op + 32 * et + 16 * rp + 8 * h) = wv; }
#pragma unroll
        for (int s = 0; s < 4; ++s) bq[s] = bqn[s];
    }
    __syncthreads();
}

constexpr int RT_ROW = 528, RT_IMG = 128 * RT_ROW;
static_assert(2 * RT_IMG <= MISC_OFF && NBT * DM * 4 <= MISC_OFF, "retention / adaLN LDS maps stay below the control words");
template <bool SCALE> __device__ __forceinline__ void ret_fill_T(const Ctx& C, LAS unsigned char* img, const bf16* src  , int ntok, int npad, float l2g, int jlast) {
    for (int ci = C.tid; ci < npad * 16; ci += 512) {
        const int j = ci % npad, ch = ci / npad;
        u32x4 v = {0u, 0u, 0u, 0u};
        if (j < ntok) v = *(const u32x4*)(src + (size_t)j * INW + 8 * ch);
        unsigned short e[8] = {(unsigned short)(v.x & 0xffff), (unsigned short)(v.x >> 16), (unsigned short)(v.y & 0xffff), (unsigned short)(v.y >> 16), (unsigned short)(v.z & 0xffff), (unsigned short)(v.z >> 16), (unsigned short)(v.w & 0xffff), (unsigned short)(v.w >> 16)};
        if (SCALE) { const float f = __builtin_amdgcn_exp2f((float)(jlast - j) * l2g);
#pragma unroll
            for (int i = 0; i < 8; i += 2) { const unsigned p = pk2(bf2f(e[i]) * f, bf2f(e[i + 1]) * f); e[i] = (unsigned short)(p & 0xffff); e[i + 1] = (unsigned short)(p >> 16); } }
        LAS bf16* dst = (LAS bf16*)(img + (8 * ch) * RT_ROW) + j;
#pragma unroll
        for (int i = 0; i < 8; ++i) dst[i * (RT_ROW / 2)] = e[i];
    }
}
__device__ __forceinline__ void r1_unit(const Ctx& C, const bf16* U, float* DT, int b, int t, int hd) {
    LAS unsigned char* lds = C.lds;
    const float l2g = log2gamma(hd);
    const bf16* base = U + (size_t)(b * SEQ + 256 * t) * INW;
    ret_fill_T<true>(C, lds, base + 1280 + 128 * hd, 256, 256, l2g, 255);
    ret_fill_T<false>(C, lds + RT_IMG, base + 1792 + 128 * hd, 256, 256, 0.f, 0);
    __syncthreads();
    const int w = C.wave, l31 = C.lane & 31, h = C.lane >> 5, et = w >> 1, dh = w & 1;
    f32x16 acc[2];
#pragma unroll
    for (int i = 0; i < 2; ++i)
#pragma unroll
        for (int r = 0; r < 16; ++r) acc[i][r] = 0.f;
#pragma unroll 4
    for (int s = 0; s < 16; ++s) {
        const bf16x8 a = *(const LAS bf16x8*)(lds + RT_IMG + (32 * et + l31) * RT_ROW + (16 * s + 8 * h) * 2);
#pragma unroll
        for (int dt = 0; dt < 2; ++dt) { const bf16x8 bb = *(const LAS bf16x8*)(lds + (32 * (2 * dh + dt) + l31) * RT_ROW + (16 * s + 8 * h) * 2); acc[dt] = MFMA32(a, bb, acc[dt]); }
    }
    float* out = DT + ((size_t)((b * NTILE_B + t) * 4 + hd) << 14);
#pragma unroll
    for (int dt = 0; dt < 2; ++dt)
#pragma unroll
        for (int r = 0; r < 16; ++r) out[(32 * et + crow(r, h)) * 128 + 32 * (2 * dh + dt) + l31] = acc[dt][r];
    __syncthreads();
}
__device__ __forceinline__ void phase_scan(const Ctx& C, const float* DT, bf16* SST, float* rsp) {
    for (int idx = C.vcu * 512 + C.tid; idx < NBP * 4 * 16384; idx += C.G * 512) {
        const int bh = idx >> 14, ed = idx & 16383, b = bh >> 2, hd = bh & 3;
        const float cd = __builtin_amdgcn_exp2f(256.f * log2gamma(hd));
        float s = 0.f;
        const size_t o0 = ((size_t)(b * NTILE_B * 4 + hd) << 14) + ed;
        float d[NTILE_B];
#pragma unroll
        for (int t = 0; t < NTILE_B; ++t) d[t] = DT[o0 + ((size_t)t << 16)];
#pragma unroll
        for (int t = 0; t < NTILE_B; ++t) { SST[o0 + ((size_t)t << 16)] = (bf16)(pk2(s, 0.f) & 0xffff); s = cd * s + d[t]; }
        rsp[((size_t)bh << 14) + (ed & 127) * 128 + (ed >> 7)] = s;
    }
}
template <bool SAMPLE> __device__ __forceinline__ void r3_unit(const Ctx& C, const bf16* U, bf16* MIX, const bf16* sst  , int row0, int hd, const float* s0  , float* snew) {
    LAS unsigned char* lds = C.lds;
    const float l2g = log2gamma(hd);
    const bf16* base = U + (size_t)row0 * INW;
    ret_fill_T<false>(C, lds, base + 1792 + 128 * hd, SAMPLE ? 16 : 256, SAMPLE ? 32 : 256, 0.f, 0);
    __syncthreads();
    const int w = C.wave, l31 = C.lane & 31, h = C.lane >> 5;
    if (!SAMPLE || w == 0) {
        const int i = 32 * w + l31;
        const int qrow = row0 + (SAMPLE ? (i < 16 ? i : 15) : i);
        bf16x8 bq[8];
#pragma unroll
        for (int s = 0; s < 8; ++s) bq[s] = *(const bf16x8*)(U + (size_t)qrow * INW + 768 + 128 * hd + 16 * s + 8 * h);
        f32x16 O[4];
#pragma unroll
        for (int et = 0; et < 4; ++et)
#pragma unroll
            for (int r = 0; r < 16; ++r) O[et][r] = 0.f;
#pragma unroll
        for (int s = 0; s < 8; ++s)
#pragma unroll
            for (int et = 0; et < 4; ++et) { const bf16x8 a = *(const bf16x8*)(sst + (size_t)(32 * et + l31) * 128 + 16 * s + 8 * h); O[et] = MFMA32(a, bq[s], O[et]); }
        const float qd = __builtin_amdgcn_exp2f((float)(i + 1) * l2g);
#pragma unroll
        for (int et = 0; et < 4; ++et)
#pragma unroll
            for (int r = 0; r < 16; ++r) O[et][r] *= qd;
        for (int kt = 0; kt <= w; ++kt) {
            f32x16 ST;
#pragma unroll
            for (int r = 0; r < 16; ++r) ST[r] = 0.f;
            const int krow = row0 + (SAMPLE ? (l31 < 16 ? l31 : 15) : 32 * kt + l31);
#pragma unroll
            for (int s = 0; s < 8; ++s) { const bf16x8 a = *(const bf16x8*)(U + (size_t)krow * INW + 1280 + 128 * hd + 16 * s + 8 * h); ST = MFMA32(a, bq[s], ST); }
#pragma unroll
            for (int r = 0; r < 16; ++r) { const int df = i - (32 * kt + crow(r, h)); ST[r] = df >= 0 ? ST[r] * __builtin_amdgcn_exp2f((float)df * l2g) : 0.f; }
#pragma unroll
            for (int sp = 0; sp < 2; ++sp) {
                u32x4 pw; pw.x = pk2(ST[8 * sp + 0], ST[8 * sp + 1]); pw.y = pk2(ST[8 * sp + 2], ST[8 * sp + 3]); pw.z = pk2(ST[8 * sp + 4], ST[8 * sp + 5]); pw.w = pk2(ST[8 * sp + 6], ST[8 * sp + 7]);
                const bf16x8 pb = __builtin_bit_cast(bf16x8, pw);
#pragma unroll
                for (int et = 0; et < 4; ++et) {
                    const LAS unsigned char* vp = lds + (32 * et + l31) * RT_ROW + (32 * kt + 16 * sp + 4 * h) * 2;
                    const s16x4 lo = *(const LAS s16x4*)vp, hi = *(const LAS s16x4*)(vp + 16);
                    const bf16x8 a = __builtin_shufflevector(lo, hi, 0, 1, 2, 3, 4, 5, 6, 7);
                    O[et] = MFMA32(a, pb, O[et]);
                }
            }
        }
        float ss = 0.f;
#pragma unroll
        for (int et = 0; et < 4; ++et)
#pragma unroll
            for (int r = 0; r < 16; ++r) ss += O[et][r] * O[et][r];
        ss += __shfl_xor(ss, 32);
        const float rn = __builtin_amdgcn_rsqf(ss * (1.0f / 128.f) + EPS);
        if (!SAMPLE || i < 16) {
            const bf16* gp = U + (size_t)qrow * INW + 2304 + 128 * hd; bf16* op = MIX + (size_t)qrow * DM + 512 + 128 * hd;
#pragma unroll
            for (int et = 0; et < 4; ++et)
#pragma unroll
                for (int rg = 0; rg < 4; ++rg) { const int e = 32 * et + 8 * rg + 4 * h; const u32x2 gw = *(const u32x2*)(gp + e);
                    const float g0 = bf2f((unsigned short)(gw.x & 0xffff)), g1 = bf2f((unsigned short)(gw.x >> 16)), g2 = bf2f((unsigned short)(gw.y & 0xffff)), g3 = bf2f((unsigned short)(gw.y >> 16));
                    u32x2 wv; wv.x = pk2(O[et][4 * rg] * rn * g0, O[et][4 * rg + 1] * rn * g1); wv.y = pk2(O[et][4 * rg + 2] * rn * g2, O[et][4 * rg + 3] * rn * g3);
                    *(u32x2*)(op + e) = wv; }
        }
    }
    __syncthreads();
}
__device__ __forceinline__ void r3s_state(const Ctx& C, const bf16* U, int row0, int hd, const float* s0, float* snew) {
    LAS unsigned char* lds = C.lds;
    const float l2g = log2gamma(hd);
    const bf16* base = U + (size_t)row0 * INW;
    LAS float* kk = (LAS float*)lds; LAS float* vv = kk + 16 * 128;
    for (int q = C.tid; q < 16 * 128; q += 512) { const int j = q >> 7, f = q & 127;
        kk[q] = bf2f(base[(size_t)j * INW + 1280 + 128 * hd + f]) * __builtin_amdgcn_exp2f((float)(15 - j) * l2g); vv[q] = bf2f(base[(size_t)j * INW + 1792 + 128 * hd + f]); }
    __syncthreads();
    const float g16 = __builtin_amdgcn_exp2f(16.f * l2g); const int e = C.tid & 127;
    for (int d = C.tid >> 7; d < 128; d += 4) { float a = g16 * s0[d * 128 + e];
#pragma unroll
        for (int j = 0; j < 16; ++j) a += kk[j * 128 + d] * vv[j * 128 + e];
        snew[d * 128 + e] = a; }
    __syncthreads();
}

__device__ __forceinline__ unsigned off_a(unsigned row, unsigned ch) { return 2048u * (row >> 3) + 512u * (ch >> 2) + 64u * (row & 7) + 16u * ((ch & 3) ^ ((row >> 2) & 3)); }
__device__ __forceinline__ void tr_read8(unsigned b0, unsigned b1, bf16x8 (&a)[4]) {
    s16x4 l0, l1, l2, l3, h0, h1, h2, h3;
    asm volatile("ds_read_b64_tr_b16 %0, %8\n\tds_read_b64_tr_b16 %1, %8 offset:512\n\tds_read_b64_tr_b16 %2, %8 offset:1024\n\tds_read_b64_tr_b16 %3, %8 offset:1536\n\t"
                 "ds_read_b64_tr_b16 %4, %9\n\tds_read_b64_tr_b16 %5, %9 offset:512\n\tds_read_b64_tr_b16 %6, %9 offset:1024\n\tds_read_b64_tr_b16 %7, %9 offset:1536\n\ts_waitcnt lgkmcnt(0)"
                 : "=&v"(l0), "=&v"(l1), "=&v"(l2), "=&v"(l3), "=&v"(h0), "=&v"(h1), "=&v"(h2), "=&v"(h3) : "v"(b0), "v"(b1) : "memory");
    a[0] = __builtin_shufflevector(l0, h0, 0, 1, 2, 3, 4, 5, 6, 7); a[1] = __builtin_shufflevector(l1, h1, 0, 1, 2, 3, 4, 5, 6, 7);
    a[2] = __builtin_shufflevector(l2, h2, 0, 1, 2, 3, 4, 5, 6, 7); a[3] = __builtin_shufflevector(l3, h3, 0, 1, 2, 3, 4, 5, 6, 7);
}
__device__ __forceinline__ void r3_pair(const Ctx& C, const bf16* U, bf16* MIX, const bf16* sst2  , int row0, int hp) {
    LAS unsigned char* lds = C.lds;
    const bf16* base = U + (size_t)row0 * INW;
    for (int ci = C.tid; ci < 2 * 4096; ci += 512) {
        const int hh = ci >> 12, row = (ci >> 4) & 255, ch = ci & 15;
        const u32x4 v = *(const u32x4*)(base + (size_t)row * INW + 1792 + 128 * (2 * hp + hh) + 8 * ch);
        *(LAS u32x4*)(lds + 65536 * hh + off_a(row, ch)) = v;
    }
    __syncthreads();
    const int w = C.wave, l31 = C.lane & 31, h = C.lane >> 5;
    const unsigned blk = (C.lane >> 4) & 1, q = (C.lane & 15) >> 2, p = C.lane & 3;
    const unsigned tb0 = 64u * (4u * h + q) + 16u * ((2u * blk + (p >> 1)) ^ (unsigned)h) + 8u * (p & 1);
    const unsigned tb1 = 64u * (4u * h + q) + 16u * ((2u * blk + (p >> 1)) ^ (2u + (unsigned)h)) + 8u * (p & 1) + 2048u;
    for (int pass = 0; pass < 2; ++pass) {
        const int hd = 2 * hp + pass, qt = pass ? 7 - w : w;
        const float l2g = log2gamma(hd);
        const unsigned img = (unsigned)(size_t)(lds + 65536 * pass);
        const int i = 32 * qt + l31, qrow = row0 + i;
        const bf16* sst = sst2 + (size_t)pass * 16384;
        bf16x8 bq[8];
#pragma unroll
        for (int s = 0; s < 8; ++s) bq[s] = *(const bf16x8*)(U + (size_t)qrow * INW + 768 + 128 * hd + 16 * s + 8 * h);
        f32x16 O[4];
#pragma unroll
        for (int et = 0; et < 4; ++et)
#pragma unroll
            for (int r = 0; r < 16; ++r) O[et][r] = 0.f;
#pragma unroll
        for (int s = 0; s < 8; ++s)
#pragma unroll
            for (int et = 0; et < 4; ++et) { const bf16x8 a = *(const bf16x8*)(sst + (size_t)(32 * et + l31) * 128 + 16 * s + 8 * h); O[et] = MFMA32(a, bq[s], O[et]); }
        const float qd = __builtin_amdgcn_exp2f((float)(i + 1) * l2g);
#pragma unroll
        for (int et = 0; et < 4; ++et)
#pragma unroll
            for (int r = 0; r < 16; ++r) O[et][r] *= qd;
        for (int kt = 0; kt <= qt; ++kt) {
            f32x16 ST;
#pragma unroll
            for (int r = 0; r < 16; ++r) ST[r] = 0.f;
            const bf16* kp = base + (size_t)(32 * kt + l31) * INW + 1280 + 128 * hd + 8 * h;
#pragma unroll
            for (int s = 0; s < 8; ++s) { const bf16x8 a = *(const bf16x8*)(kp + 16 * s); ST = MFMA32(a, bq[s], ST); }
#pragma unroll
            for (int r = 0; r < 16; ++r) { const int df = i - (32 * kt + crow(r, h)); ST[r] = df >= 0 ? ST[r] * __builtin_amdgcn_exp2f((float)df * l2g) : 0.f; }
#pragma unroll
            for (int sp = 0; sp < 2; ++sp) {
                u32x4 pw; pw.x = pk2(ST[8 * sp + 0], ST[8 * sp + 1]); pw.y = pk2(ST[8 * sp + 2], ST[8 * sp + 3]); pw.z = pk2(ST[8 * sp + 4], ST[8 * sp + 5]); pw.w = pk2(ST[8 * sp + 6], ST[8 * sp + 7]);
                const bf16x8 pb = __builtin_bit_cast(bf16x8, pw);
                bf16x8 av[4];
                const unsigned ko = img + 2048u * (unsigned)(4 * kt + 2 * sp);
                tr_read8(ko + tb0, ko + tb1, av);
                __builtin_amdgcn_sched_barrier(0);
#pragma unroll
                for (int et = 0; et < 4; ++et) O[et] = MFMA32(av[et], pb, O[et]);
            }
        }
        float ss = 0.f;
#pragma unroll
        for (int et = 0; et < 4; ++et)
#pragma unroll
            for (int r = 0; r < 16; ++r) ss += O[et][r] * O[et][r];
        ss += __shfl_xor(ss, 32);
        const float rn = __builtin_amdgcn_rsqf(ss * (1.0f / 128.f) + EPS);
        const bf16* gp = U + (size_t)qrow * INW + 2304 + 128 * hd; bf16* op = MIX + (size_t)qrow * DM + 512 + 128 * hd;
#pragma unroll
        for (int et = 0; et < 4; ++et)
#pragma unroll
            for (int rg = 0; rg < 4; ++rg) { const int e = 32 * et + 8 * rg + 4 * h; const u32x2 gw = *(const u32x2*)(gp + e);
                const float g0 = bf2f((unsigned short)(gw.x & 0xffff)), g1 = bf2f((unsigned short)(gw.x >> 16)), g2 = bf2f((unsigned short)(gw.y & 0xffff)), g3 = bf2f((unsigned short)(gw.y >> 16));
                u32x2 wv; wv.x = pk2(O[et][4 * rg] * rn * g0, O[et][4 * rg + 1] * rn * g1); wv.y = pk2(O[et][4 * rg + 2] * rn * g2, O[et][4 * rg + 3] * rn * g3);
                *(u32x2*)(op + e) = wv; }
    }
    __syncthreads();
}

__device__ __forceinline__ bf16x8 tr_read2(unsigned a0, unsigned a1) {
    s16x4 lo, hi;
    asm volatile("ds_read_b64_tr_b16 %0, %2\n\tds_read_b64_tr_b16 %1, %3\n\ts_waitcnt lgkmcnt(0)" : "=&v"(lo), "=&v"(hi) : "v"(a0), "v"(a1) : "memory");
    return __builtin_shufflevector(lo, hi, 0, 1, 2, 3, 4, 5, 6, 7);
}
__device__ __forceinline__ void r3_one(const Ctx& C, const bf16* U, bf16* MIX, const bf16* sst  , int row0, int hd, int pf) {
    LAS unsigned char* lds = C.lds;
    const bf16* base = U + (size_t)row0 * INW;
    const int w = C.wave, l31 = C.lane & 31, h = C.lane >> 5;
    const int i = 32 * w + l31, qrow = row0 + i;
    for (int ci = C.tid; ci < 4096 + 2048; ci += 512) {
        if (ci < 4096) { const int row = ci >> 4, ch = ci & 15; *(LAS u32x4*)(lds + off_a(row, ch)) = *(const u32x4*)(base + (size_t)row * INW + 1792 + 128 * hd + 8 * ch); }
        else { const int cj = ci - 4096, row = cj >> 4, ch = cj & 15; *(LAS u32x4*)(lds + 65536 + off_a(row, ch)) = *(const u32x4*)(sst + (size_t)row * 128 + 8 * ch); }
    }
    __syncthreads();
    const unsigned blk = (C.lane >> 4) & 1, q = (C.lane & 15) >> 2, p = C.lane & 3;
    const unsigned tb0 = 64u * (4u * h + q) + 16u * ((2u * blk + (p >> 1)) ^ (unsigned)h) + 8u * (p & 1);
    const unsigned tb1 = 64u * (4u * h + q) + 16u * ((2u * blk + (p >> 1)) ^ (2u + (unsigned)h)) + 8u * (p & 1) + 2048u;
    const float l2g = log2gamma(hd);
    const unsigned img = (unsigned)(size_t)lds;
    f32x16 O[4];
#pragma unroll
    for (int et = 0; et < 4; ++et)
#pragma unroll
        for (int r = 0; r < 16; ++r) O[et][r] = 0.f;
    bf16x8 bq[8];
#pragma unroll
    for (int s = 0; s < 8; ++s) bq[s] = *(const bf16x8*)(U + (size_t)qrow * INW + 768 + 128 * hd + 16 * s + 8 * h);
    if (!(pf & 32)) {
#pragma unroll
    for (int s = 0; s < 8; ++s)
#pragma unroll
        for (int et = 0; et < 4; ++et) { const bf16x8 a = *(const LAS bf16x8*)(lds + 65536 + off_a(32 * et + l31, 2 * s + h)); O[et] = MFMA32(a, bq[s], O[et]); }
    }
    __syncthreads();
    for (int ci = C.tid; ci < 4096; ci += 512) { const int row = ci >> 4, ch = ci & 15; *(LAS u32x4*)(lds + 65536 + off_a(row, ch)) = *(const u32x4*)(base + (size_t)row * INW + 1280 + 128 * hd + 8 * ch); }
    __syncthreads();
    const float qd = __builtin_amdgcn_exp2f((float)(i + 1) * l2g);
#pragma unroll
    for (int et = 0; et < 4; ++et)
#pragma unroll
        for (int r = 0; r < 16; ++r) O[et][r] *= qd;
    const float ai = __builtin_amdgcn_exp2f((float)i * l2g), g32 = __builtin_amdgcn_exp2f(-32.f * l2g);
    float cr[16];
#pragma unroll
    for (int r = 0; r < 16; ++r) cr[r] = __builtin_amdgcn_exp2f(-(float)crow(r, h) * l2g);
    float ag = ai;
    for (int kt = 0; kt <= ((pf & 64) ? -1 : w); ++kt) {
        f32x16 ST;
#pragma unroll
        for (int r = 0; r < 16; ++r) ST[r] = 0.f;
#pragma unroll
        for (int s = 0; s < 8; ++s) { const bf16x8 a = *(const LAS bf16x8*)(lds + 65536 + off_a(32 * kt + l31, 2 * s + h)); ST = MFMA32(a, bq[s], ST); }
        if (kt == w) {
#pragma unroll
            for (int r = 0; r < 16; ++r) ST[r] = (l31 - crow(r, h)) >= 0 ? ST[r] * (ag * cr[r]) : 0.f;
        } else {
#pragma unroll
            for (int r = 0; r < 16; ++r) ST[r] *= ag * cr[r];
        }
        ag *= g32;
#pragma unroll
        for (int sp = 0; sp < 2; ++sp) {
            u32x4 pw; pw.x = pk2(ST[8 * sp + 0], ST[8 * sp + 1]); pw.y = pk2(ST[8 * sp + 2], ST[8 * sp + 3]); pw.z = pk2(ST[8 * sp + 4], ST[8 * sp + 5]); pw.w = pk2(ST[8 * sp + 6], ST[8 * sp + 7]);
            const bf16x8 pb = __builtin_bit_cast(bf16x8, pw);
            bf16x8 av[4];
            const unsigned ko = img + 2048u * (unsigned)(4 * kt + 2 * sp);
            tr_read8(ko + tb0, ko + tb1, av);
            __builtin_amdgcn_sched_barrier(0);
#pragma unroll
            for (int et = 0; et < 4; ++et) O[et] = MFMA32(av[et], pb, O[et]);
        }
    }
    float ss = 0.f;
#pragma unroll
    for (int et = 0; et < 4; ++et)
#pragma unroll
        for (int r = 0; r < 16; ++r) ss += O[et][r] * O[et][r];
    ss += __shfl_xor(ss, 32);
    const float rn = __builtin_amdgcn_rsqf(ss * (1.0f / 128.f) + EPS);
    const bf16* gp = U + (size_t)qrow * INW + 2304 + 128 * hd; bf16* op = MIX + (size_t)qrow * DM + 512 + 128 * hd;
    if (pf & 128) { if (ss == 123.456f) op[0] = 0; } else
#pragma unroll
    for (int et = 0; et < 4; ++et)
#pragma unroll
        for (int rp = 0; rp < 2; ++rp) {
            float x[8];
#pragma unroll
            for (int j = 0; j < 4; ++j) { const auto r = __builtin_amdgcn_permlane32_swap(__float_as_uint(O[et][8 * rp + j] * rn), __float_as_uint(O[et][8 * rp + 4 + j] * rn), false, false);
                x[j] = __uint_as_float(r[0]); x[4 + j] = __uint_as_float(r[1]); }
            const int e = 32 * et + 16 * rp + 8 * h; const u32x4 gw = *(const u32x4*)(gp + e);
            u32x4 wv;
            wv.x = pk2(x[0] * __uint_as_float(gw.x << 16), x[1] * __uint_as_float(gw.x & 0xffff0000u)); wv.y = pk2(x[2] * __uint_as_float(gw.y << 16), x[3] * __uint_as_float(gw.y & 0xffff0000u));
            wv.z = pk2(x[4] * __uint_as_float(gw.z << 16), x[5] * __uint_as_float(gw.z & 0xffff0000u)); wv.w = pk2(x[6] * __uint_as_float(gw.w << 16), x[7] * __uint_as_float(gw.w & 0xffff0000u));
            *(u32x4*)(op + e) = wv; }
    __syncthreads();
}
__device__ __forceinline__ void r1_tr(const Ctx& C, const bf16* U, float* DT, int b, int t, int hd) {
    LAS unsigned char* lds = C.lds;
    const float l2g = log2gamma(hd);
    const bf16* base = U + (size_t)(b * SEQ + 256 * t) * INW;
    for (int ci = C.tid; ci < 2 * 4096; ci += 512) {
        const int im = ci >> 12, row = (ci >> 4) & 255, ch = ci & 15;
        u32x4 v = *(const u32x4*)(base + (size_t)row * INW + (im ? 1280 : 1792) + 128 * hd + 8 * ch);
        if (im) { const float f = __builtin_amdgcn_exp2f((float)(255 - row) * l2g);
            v.x = pk2(__uint_as_float(v.x << 16) * f, __uint_as_float(v.x & 0xffff0000u) * f); v.y = pk2(__uint_as_float(v.y << 16) * f, __uint_as_float(v.y & 0xffff0000u) * f);
            v.z = pk2(__uint_as_float(v.z << 16) * f, __uint_as_float(v.z & 0xffff0000u) * f); v.w = pk2(__uint_as_float(v.w << 16) * f, __uint_as_float(v.w & 0xffff0000u) * f); }
        *(LAS u32x4*)(lds + 65536 * im + off_a(row, ch)) = v;
    }
    __syncthreads();
    const int w = C.wave, l31 = C.lane & 31, h = C.lane >> 5, et = w >> 1, dh = w & 1;
    const unsigned blk = (C.lane >> 4) & 1, q = (C.lane & 15) >> 2, p = C.lane & 3;
    const unsigned tb0 = 64u * (4u * h + q) + 16u * ((2u * blk + (p >> 1)) ^ (unsigned)h) + 8u * (p & 1);
    const unsigned tb1 = 64u * (4u * h + q) + 16u * ((2u * blk + (p >> 1)) ^ (2u + (unsigned)h)) + 8u * (p & 1) + 2048u;
    const unsigned img = (unsigned)(size_t)lds;
    f32x16 acc[2];
#pragma unroll
    for (int i = 0; i < 2; ++i)
#pragma unroll
        for (int r = 0; r < 16; ++r) acc[i][r] = 0.f;
    const unsigned ta0 = img + tb0 + 512u * et, ta1 = img + tb1 + 512u * et, tk0 = img + 65536u + tb0 + 512u * (2 * dh), tk1 = img + 65536u + tb1 + 512u * (2 * dh);
    for (int s = 0; s < 16; ++s) {
        const unsigned ko = 4096u * (unsigned)s;
        s16x4 a0, a1, c0, c1, d0, d1;
        asm volatile("ds_read_b64_tr_b16 %0, %6\n\tds_read_b64_tr_b16 %1, %7\n\tds_read_b64_tr_b16 %2, %8\n\tds_read_b64_tr_b16 %3, %9\n\tds_read_b64_tr_b16 %4, %8 offset:512\n\tds_read_b64_tr_b16 %5, %9 offset:512\n\ts_waitcnt lgkmcnt(0)"
                     : "=&v"(a0), "=&v"(a1), "=&v"(c0), "=&v"(c1), "=&v"(d0), "=&v"(d1) : "v"(ta0 + ko), "v"(ta1 + ko), "v"(tk0 + ko), "v"(tk1 + ko) : "memory");
        const bf16x8 a = __builtin_shufflevector(a0, a1, 0, 1, 2, 3, 4, 5, 6, 7), b0 = __builtin_shufflevector(c0, c1, 0, 1, 2, 3, 4, 5, 6, 7), b1 = __builtin_shufflevector(d0, d1, 0, 1, 2, 3, 4, 5, 6, 7);
        __builtin_amdgcn_sched_barrier(0);
        acc[0] = MFMA32(a, b0, acc[0]); acc[1] = MFMA32(a, b1, acc[1]);
    }
    float* out = DT + ((size_t)((b * NTILE_B + t) * 4 + hd) << 14);
#pragma unroll
    for (int dt = 0; dt < 2; ++dt)
#pragma unroll
        for (int r = 0; r < 16; ++r) out[(32 * et + crow(r, h)) * 128 + 32 * (2 * dh + dt) + l31] = acc[dt][r];
    __syncthreads();
}


#define XB_TMO      128
#define XB_XCNT(j)  (256  + 64 * (j))
#define XB_XSUB(j)  (1280 + 64 * (j))
#define XB_XGEN(j)  (2304 + 64 * (j))
#define XB_TOP      3328
#define XB_TOPGEN   3392
#define XCD_BAR_WORDS 3456
#define XB_SPIN_CAP (1u << 18)

__device__ __forceinline__ unsigned xb_ld(unsigned* p)              { return __hip_atomic_load(p, __ATOMIC_RELAXED, __HIP_MEMORY_SCOPE_AGENT); }
__device__ __forceinline__ unsigned xb_add(unsigned* p, unsigned v) { return __hip_atomic_fetch_add(p, v, __ATOMIC_RELAXED, __HIP_MEMORY_SCOPE_AGENT); }
__device__ __forceinline__ unsigned xb_xcc_id() { return (unsigned)__builtin_amdgcn_s_getreg((3 << 11) | 20) & 0xFu; }
#define XB_SPIN(cond, bar) do { unsigned _sp = 0; while (cond) { __builtin_amdgcn_s_sleep(1); \
    if ((++_sp & 255u) == 0u) { if (xb_ld(&(bar)[XB_TMO])) break; if (_sp > XB_SPIN_CAP) { atomicAdd(&(bar)[XB_TMO], 1u); break; } } } } while (0)

struct XcdBarrier {
    unsigned* bar; unsigned x;
    volatile LAS unsigned* st;
};

__device__ __forceinline__ XcdBarrier xcd_barrier_post(unsigned* bar, volatile LAS unsigned* st) {
    XcdBarrier b; b.bar = bar; b.x = xb_xcc_id(); b.st = st;
    if (threadIdx.x == 0) (void)xb_add(&bar[XB_XCNT(b.x)], 1u);
    return b;
}
__device__ __forceinline__ void xcd_barrier_complete(unsigned* bar, unsigned x, unsigned& nloc, unsigned& nx) {
    const unsigned G = gridDim.x * gridDim.y * gridDim.z;
    unsigned sum, cnt, mine, sp = 0u;
    for (;;) {
        sum = 0u; cnt = 0u; mine = 0u;
#pragma unroll
        for (unsigned j = 0; j < 16; ++j) { const unsigned c = xb_ld(&bar[XB_XCNT(j)]); sum += c; cnt += (c > 0u) ? 1u : 0u; mine = (j == x) ? c : mine; }
        if (sum == G) break;
        __builtin_amdgcn_s_sleep(1);
        if ((++sp & 255u) == 0u) { if (xb_ld(&bar[XB_TMO])) break; if (sp > XB_SPIN_CAP) { atomicAdd(&bar[XB_TMO], 1u); break; } }
    }
    nloc = mine > 0u ? mine : 1u; nx = cnt > 0u ? cnt : 1u;
}

__device__ __forceinline__ void xcd_barrier(const XcdBarrier& b, const int tid) {
    asm volatile("s_waitcnt vmcnt(0)" ::: "memory");
    __syncthreads();
    if (tid == 0) {
        unsigned* bar = b.bar;
        __builtin_amdgcn_s_waitcnt(0);
        unsigned nloc = b.st[0], nx = b.st[1];
        if (nloc == 0u) { xcd_barrier_complete(bar, b.x, nloc, nx); b.st[0] = nloc; b.st[1] = nx; }
        const unsigned old = xb_add(&bar[XB_XSUB(b.x)], 1u);
        const unsigned gen = old / nloc;
        if (old + 1u == (gen + 1u) * nloc) {
            __builtin_amdgcn_fence(__ATOMIC_RELEASE, "agent");
            asm volatile("s_waitcnt vmcnt(0)" ::: "memory");
            const unsigned og = xb_add(&bar[XB_TOP], 1u);
            const unsigned tg = og / nx;
            if (og + 1u == (tg + 1u) * nx) xb_add(&bar[XB_TOPGEN], 1u);
            else XB_SPIN(xb_ld(&bar[XB_TOPGEN]) == tg, bar);
            __builtin_amdgcn_fence(__ATOMIC_ACQUIRE, "agent");
            xb_add(&bar[XB_XGEN(b.x)], 1u);
            asm volatile("s_waitcnt vmcnt(0)" ::: "memory");
        } else {
            XB_SPIN(xb_ld(&bar[XB_XGEN(b.x)]) == gen, bar);
            __builtin_amdgcn_fence(__ATOMIC_ACQUIRE, "agent");
            asm volatile("s_waitcnt vmcnt(0)" ::: "memory");
        }
    }
    __syncthreads();
}

constexpr int NPHASE = 3 + 7 * NLAYER;
#ifndef PHMASK
#define PHMASK 0xFFFF
#endif
#define PHON(i) ((PHMASK >> (i)) & 1)
#ifndef MK_LAUNCHES
#define MK_LAUNCHES 1
#endif
__global__ void __launch_bounds__(512, 2) fwd_kernel(Params P) {
    extern __shared__ __attribute__((aligned(16))) unsigned char lds_raw[];
#if MK_LAUNCHES
    if (threadIdx.x < 64) ((LAS unsigned*)((LAS unsigned char*)lds_raw + MISC_OFF))[threadIdx.x] = 0u;
    __syncthreads();
    const XcdBarrier bar = xcd_barrier_post((unsigned*)(P.ws + WS_CTL), (volatile LAS unsigned*)((LAS unsigned char*)lds_raw + MISC_OFF));
#endif
    const int wave0 = __builtin_amdgcn_readfirstlane((int)threadIdx.x >> 6);
    for (int ph = P.ph_lo; ph < P.ph_hi; ++ph) {
        unsigned char* ws = P.ws; asm volatile("" : "+s"(ws));
        float* out = P.out; asm volatile("" : "+s"(out));
#define MKCTX() Ctx C; { unsigned z_ = 0u; asm volatile("" : "+v"(z_)); int tid_ = wave0 * 64 + (int)__builtin_amdgcn_mbcnt_hi(~0u, __builtin_amdgcn_mbcnt_lo(~0u, z_)); C.lds = (LAS unsigned char*)lds_raw; C.tid = tid_; C.lane = C.tid & 63; C.wave = __builtin_amdgcn_readfirstlane(C.tid >> 6); \
        int G_ = gridDim.x, bx_ = blockIdx.x; asm volatile("" : "+s"(G_), "+s"(bx_)); C.G = G_; C.vcu = (G_ % 8 == 0) ? (bx_ % 8) * (G_ / 8) + bx_ / 8 : bx_; }
        bf16* const XG = (bf16*)(ws + WS_XG); bf16* const U = (bf16*)(ws + WS_U); bf16* const MIX = (bf16*)(ws + WS_MIX); bf16* const HID = (bf16*)(ws + WS_HID);
        float* const DT = (float*)(ws + WS_DT); bf16* const SST = (bf16*)(ws + WS_SST);
        const float* const cs = (const float*)(ws + WS_CS);
        bf16* const XB = (bf16*)(ws + WS_XB) - (size_t)MP * DM; float* const SSA = (float*)(ws + WS_SSP); float* const SSB = SSA + MT;
        if (ph == 0) { if (PHON(0)) { MKCTX(); phase_prologue(C, P); } }
        else if (ph == 1 && !PHON(1)) { }
        else if (ph == NPHASE - 1) { if (PHON(8)) { MKCTX(); phase_final(C, XG, SSB, out + O_Y); } }
        else {
            const int l = ph == 1 ? 0 : (ph - 2) / 7, k = ph == 1 ? 7 : (ph - 2) % 7;
            const float* modl = (const float*)(ws + WS_MOD) + (size_t)l * NBT * NMOD;
            if (k == 0 || k == 2 || k == 4 || k == 5 || k == 6 || k == 7) { if (PHON(2)) { MKCTX();
                if (k == 7) phase_prologue2(C, P);
                if (k == 2) { phase_scan(C, DT, SST, out + O_RSP + (size_t)l * 131072);
                    for (int u = ((int)blockIdx.x + C.G - 64 % C.G) % C.G; u < DBS * 4; u += C.G) { const int hd = u & 3, j = u >> 2; const size_t so = ((size_t)(l * DBS + j) * 4 + hd) << 14;
                        r3s_state(C, U, MP + 16 * j, hd, P.in[I_SR] + so, out + O_RSS + so); } }
                if (k == 6) phase_fz<KS4>(C, XB, XG, (const float*)(ws + WS_Y4), SSB, modl, 5 * DM, (const float*)(ws + WS_GS) + (size_t)(2 * l + 2) * NBT * DM);
                const int ncall = (k == 4 || k == 5 || (k == 0 && l == 0)) ? 2 : 1;
                for (int sc = 0; sc < ncall; ++sc) {
                    int sub = 0, cidx = (int)blockIdx.x, Gc = C.G;
                    const bool cv = k == 7 || (k == 0 && sc == 1);
                    if (cv) { constexpr int n1 = INW / 256, n2 = DFF / 256; const int bx = (int)blockIdx.x; Gc = 1 << 20; cidx = 1 << 20;
                        if (k == 7) { if (bx < n1) { sub = 0; cidx = bx; } }
                        else { const int i = bx - (C.G - (n1 + 2 * n2)); if (i >= 0 && i < n2) { sub = 1; cidx = i; } else if (i >= n2 && i < n2 + n1) { sub = 2; cidx = i - n2; } else if (i >= n2 + n1 && i < n1 + 2 * n2) { sub = 3; cidx = i - n2 - n1; } } }
                    const int sl = cv ? (sub >> 1) : l; const bool cup = (sub & 1) != 0;
                    const int st = cv ? (cup ? 1 : 0) : k == 0 ? 0 : k == 2 ? 2 : k == 4 ? (sc ? 1 : 2) : k == 5 ? (sc ? 3 : 1) : 3;
                    const bool samp = k == 2 || ((k == 4 || k == 5) && sc == 1);
                    const int N = st == 0 ? INW : (st == 1 ? DFF : DM), ld = st == 3 ? LDH : DM, Kfull = st == 3 ? DFF : DM;
                    const int ks = (samp && st == 2) ? KS2 : ((samp && st == 3) ? KS4 : 1), K = Kfull / ks;
                    const int M = cv ? 256 : (samp ? MS : (k == 0 ? MT : MP)), pm0 = samp ? MP / 256 : 0;
                    const bf16* A = cv ? (const bf16*)(ws + WS_SHM) + (size_t)sub * 256 * DM : (st == 0 || st == 1) ? XG : (st == 2 ? MIX : HID);
                    const bf16* Bt = st == 0 ? (const bf16*)(ws + WS_WIN) + (size_t)sl * INW * DM : st == 1 ? (const bf16*)(ws + WS_WUP) + (size_t)sl * DFF * DM : st == 2 ? (const bf16*)(ws + WS_WOUT) + (size_t)sl * DM * DM : (const bf16*)(ws + WS_WDN) + (size_t)sl * DM * LDH;
                    pg8::Gemm g{A, Bt, M, N, K, ld, DM * 2, ((st == 2 || st == 3) && !samp && !cv) ? (const char*)XG : nullptr}; pg8::StaticOrder S; S.init(M, N, Gc, cidx, pm0, ks, K * 2);
                    EpiAll E; E.kind = cv ? 4 : (samp && st == 2) ? 5 : (samp && st == 3) ? 6 : st == 0 ? 0 : st == 1 ? 1 : st == 2 ? 2 : 3; E.l = cv ? sub : l; E.ws = ws; E.out = out;
                    int tq = C.tid; asm volatile("" : "+v"(tq));
                    pg8::gemm_phase<EpiAll, pg8::StaticOrder, true, true>(C.lds, g, S, E, tq);
                } }
            } else if (k == 1) {
                if (PHON(5)) { MKCTX(); const Ctx C0 = C;
                    if (P.pad & 1) for (int su = C0.vcu; su < 256; su += C0.G) { Ctx C = C0; asm volatile("" : "+v"(C.tid)); C.lane = C.tid & 63;
                        att_super(C, U, MIX, P.in[I_SINK] + l * 8, (const float*)(ws + WS_BT), su >> 7, (su >> 6) & 1, 4 * (su & 63)); }
                    for (int u = C0.vcu; u < 704; u += C0.G) {
                    Ctx C = C0; asm volatile("" : "+v"(C.tid)); C.lane = C.tid & 63;
                    if (u < 512) { if (!(P.pad & 2)) continue; const int hd = u & 3, t = (u >> 2) & 63, b = u >> 8; r1_tr(C, U, DT, b, t, hd); }
                    else if (u < 576) { if (!(P.pad & 4)) continue; const int v = u - 512, kvh = v & 1, j = v >> 1; att_unit<true>(C, U, MIX, P.in[I_SINK] + l * 8, (const float*)(ws + WS_BT), P.in[I_CK] + (size_t)l * DBS * 16384, P.in[I_CV] + (size_t)l * DBS * 16384, j, 0, kvh); }
                    else { if (!(P.pad & 4)) continue; const int v = u - 576, hd = v & 3, j = v >> 2; const size_t so = ((size_t)(l * DBS + j) * 4 + hd) << 14;
                        r3_unit<true>(C, U, MIX, (const bf16*)(ws + WS_SS0) + so, MP + 16 * j, hd, P.in[I_SR] + so, out + O_RSS + so); }
                } }
            } else if (k == 3) {
                if (PHON(7)) { MKCTX(); for (int u = C.vcu; u < 512; u += C.G) {
                    const int hd = u & 3, t = (u >> 2) & 63, b = u >> 8; r3_one(C, U, MIX, SST + ((size_t)((b * NTILE_B + t) * 4 + hd) << 14), b * SEQ + 256 * t, hd, P.pad);
                }
                if (P.pad & 8) phase_fz<KS2>(C, XB, XG, (const float*)(ws + WS_Y2), SSA, modl, 2 * DM, (const float*)(ws + WS_GS) + (size_t)(2 * l + 1) * NBT * DM); }
            }
        }
#if MK_LAUNCHES
        if (ph + 1 < P.ph_hi) { MKCTX(); xcd_barrier(bar, C.tid); }
#endif
    }
}

extern "C" void kernel_launch(void* const* d_in, const int* in_sizes, int n_in, void* d_out, int out_size, void* d_ws, size_t ws_size, hipStream_t stream) {
    static int grid = 0;
    if (grid == 0) {
        if (n_in != 18 || in_sizes[0] != MP * DM || (size_t)out_size != O_END || ws_size < WS_END) {
            fprintf(stderr, "kernel_launch: unexpected shapes (n_in %d, in0 %d, out %d, ws %zu need %zu)\n", n_in, n_in > 0 ? in_sizes[0] : -1, out_size, ws_size, (size_t)WS_END); grid = -1; return; }
        int dev = 0, cus = 0, per_cu = 0;
        if (hipGetDevice(&dev) != hipSuccess || hipDeviceGetAttribute(&cus, hipDeviceAttributeMultiprocessorCount, dev) != hipSuccess) { grid = -1; return; }
        if (hipFuncSetAttribute((const void*)fwd_kernel, hipFuncAttributeMaxDynamicSharedMemorySize, LDS_BYTES) != hipSuccess) { fprintf(stderr, "kernel_launch: hipFuncSetAttribute failed\n"); grid = -1; return; }
        if (hipOccupancyMaxActiveBlocksPerMultiprocessor(&per_cu, (const void*)fwd_kernel, 512, LDS_BYTES) != hipSuccess || per_cu < 1) { fprintf(stderr, "kernel_launch: occupancy query gave %d\n", per_cu); (void)hipGetLastError(); per_cu = 1; }
        grid = cus;
    }
    if (grid < 0) return;
    Params p{};
#if MK_LAUNCHES
    if (hipMemsetAsync((char*)d_ws + WS_CTL, 0, CTL_ZERO_BYTES, stream) != hipSuccess) { fprintf(stderr, "kernel_launch: memset of the barrier words failed\n"); return; }
#endif
    for (int i = 0; i < 18; ++i) p.in[i] = (const float*)d_in[i];
    p.out = (float*)d_out; p.ws = (unsigned char*)d_ws; p.pad = 15;
#if MK_LAUNCHES
    p.ph_lo = 0; p.ph_hi = NPHASE; p.coop = 1;
    void* args[] = {&p};
    hipError_t e = hipLaunchCooperativeKernel((const void*)fwd_kernel, dim3(grid), dim3(512), args, LDS_BYTES, stream);
    if (e != hipSuccess) fprintf(stderr, "kernel_launch: cooperative launch failed: %s (grid %d)\n", hipGetErrorString(e), grid);
#else
    for (int ph = 0; ph < NPHASE; ++ph) { p.ph_lo = ph; p.ph_hi = ph + 1; p.coop = 0;
#if defined(DUPK)
        { const int kk = ph == 0 ? -1 : (ph == 1 ? -2 : (ph == NPHASE - 1 ? 99 : (ph - 2) % 7));
          if (kk == DUPK) { p.pad = DUPU; hipLaunchKernelGGL(fwd_kernel, dim3(grid), dim3(512), LDS_BYTES, stream, p); } }
#endif
        p.pad = 15; hipLaunchKernelGGL(fwd_kernel, dim3(grid), dim3(512), LDS_BYTES, stream, p);
    }
#endif
}
```

```cpp
#include <hip/hip_runtime.h>
#include <hip/hip_cooperative_groups.h>
#include <cstdio>
#include <cstdint>
namespace cg = cooperative_groups;

namespace pg8 {
#define PG8_LAS __attribute__((address_space(3)))
typedef unsigned short bf16_t;
typedef short bf16x8 __attribute__((ext_vector_type(8)));
typedef float f32x4 __attribute__((ext_vector_type(4)));
typedef unsigned u32x4 __attribute__((ext_vector_type(4)));
constexpr int BM = 256, BK = 64, HALF = 128, HTB = HALF * BK * 2  , STAGE_BYTES = 8 * HTB, NXCD = 8, WGM = 8;

__host__ __device__ __forceinline__ int lds_byte(int r, int c) { const int st = (r >> 4) * 2 + (c >> 5), rr = r & 15, cc = c & 31, ob = rr * 64 + cc * 2; return st * 1024 + (ob ^ (((ob >> 9) & 1) << 5)); }
__host__ __device__ __forceinline__ void stage_rc(int b, int& R, int& C) { const int st = b / 1024, sb = b % 1024, swz = sb ^ (((sb >> 9) & 1) << 5); R = (st >> 1) * 16 + swz / 64; C = (st & 1) * 32 + (swz % 64) / 2; }
__host__ __device__ __forceinline__ int perm32(int rho) { const int n = rho >> 4, i = rho & 15; return 8 * (i >> 2) + 4 * n + (i & 3); }

struct Unit { int pm, pn, koff; };
struct Gemm { const bf16_t* A; const bf16_t* Bt; int M, N, K, ld, pf; const char* px; };

struct StaticOrder {
    int nM, nN, nwg, G, c, pm0, ks, kbytes;
    __host__ __device__ void init(int M, int N, int G_, int c_, int pm0_ = 0, int ks_ = 1, int kbytes_ = 0) { nM = M / BM; nN = N / BM; ks = ks_; nwg = nM * nN * ks; G = G_; c = c_; pm0 = pm0_; kbytes = kbytes_; }
    __host__ __device__ bool next(int i, Unit& u) const {
        const long L = (long)i * G + c; if (L >= nwg) return false;
        if (ks > 1) { const int sub = (int)L % ks, tile = (int)L / ks; u.pm = pm0 + tile % nM; u.pn = tile / nM; u.koff = sub * kbytes; return true; }
        int wgid = (int)L; { const int q = nwg / NXCD, r = nwg % NXCD, xcd = wgid % NXCD, off = wgid / NXCD; wgid = (xcd < r ? xcd * (q + 1) : r * (q + 1) + (xcd - r) * q) + off; }
        const int nig = WGM * nN, gid = wgid / nig, fm = gid * WGM, gsz = (nM - fm) < WGM ? (nM - fm) : WGM;
        u.pm = pm0 + fm + ((wgid % nig) % gsz); u.pn = (wgid % nig) / gsz; u.koff = 0; return true;
    }
    __device__ __forceinline__ void a_ready(const Unit&) const {}
    __device__ __forceinline__ void done(const Unit&) const {}
};
typedef float f32x2 __attribute__((ext_vector_type(2)));
typedef unsigned u32x2 __attribute__((ext_vector_type(2)));
typedef __bf16 bf16v2 __attribute__((ext_vector_type(2)));
__device__ __forceinline__ unsigned pk2(float lo, float hi) { const f32x2 v = {lo, hi}; return __builtin_bit_cast(unsigned, __builtin_convertvector(v, bf16v2)); }
template <class Epi, class Sched, bool ALIGN_EPI = false, bool SP2 = false>
__device__ __forceinline__ void gemm_phase(PG8_LAS unsigned char* lds, const Gemm g, const Sched& S, const Epi& E, const int tid) {
    const int wid = __builtin_amdgcn_readfirstlane(tid >> 6), lane = tid & 63, wr = wid >> 2, wc = wid & 3, fr = lane & 15, fq = lane >> 4;
    const int K = g.K, nt = K / BK;
    unsigned voffA, voffB;
    { int R, C; stage_rc(tid * 16, R, C); const int Rb = E.perm() ? ((R & ~31) + perm32(R & 31)) : R;
        voffA = (unsigned)(R * g.ld + C) * 2u; voffB = (unsigned)(Rb * g.ld + C) * 2u; }
    const size_t qstep = (size_t)64 * g.ld * 2;
    const size_t kstep = (size_t)(BK * 2);
    const size_t hstep = (size_t)HALF * g.ld * 2;
    const size_t tstep = 2 * hstep;
    const unsigned ldsw = (unsigned)wid * 1024u;
    const int aoff = lds_byte(wr * 64 + fr, fq * 8), boff = lds_byte(wc * 32 + fr, fq * 8);
#define PG8_SA(b, h) (((b) * 2 + (h)) * HTB)
#define PG8_SB(b, h) ((4 + (b) * 2 + (h)) * HTB)
#define PG8_STAGE(bufoff, gbase, voff) do { _Pragma("unroll") for (int _i = 0; _i < 2; ++_i) \
        __builtin_amdgcn_global_load_lds((const unsigned*)((const char*)(gbase) + _i * qstep + (voff)), (PG8_LAS unsigned*)(lds + (bufoff) + ldsw + _i * 8192), 16, 0, 0); } while (0)
#define PG8_LDA(dst, b, h) do { _Pragma("unroll") for (int m = 0; m < 4; ++m) _Pragma("unroll") for (int k = 0; k < 2; ++k) dst[m][k] = *(const PG8_LAS bf16x8*)(lds + PG8_SA(b, h) + aoff + m * 2048 + k * 1024); } while (0)
#define PG8_LDB(dst, b, h) do { _Pragma("unroll") for (int n = 0; n < 2; ++n) _Pragma("unroll") for (int k = 0; k < 2; ++k) dst[n][k] = *(const PG8_LAS bf16x8*)(lds + PG8_SB(b, h) + boff + n * 2048 + k * 1024); } while (0)
#define PG8_MMA(ai, bj, At, Bt) do { __builtin_amdgcn_s_setprio(1); _Pragma("unroll") for (int m = 0; m < 4; ++m) _Pragma("unroll") for (int n = 0; n < 2; ++n) _Pragma("unroll") for (int k = 0; k < 2; ++k) \
        acc[ai][bj][m][n] = __builtin_amdgcn_mfma_f32_16x16x32_bf16(Bt[n][k], At[m][k], acc[ai][bj][m][n], 0, 0, 0); __builtin_amdgcn_s_setprio(0); } while (0)
#define PG8_WAIT_V(n) asm volatile("s_waitcnt vmcnt(" #n ")" ::: "memory")
#define PG8_WAIT_L(n) asm volatile("s_waitcnt lgkmcnt(" #n ")" ::: "memory")
#define PG8_BAR __builtin_amdgcn_s_barrier()
#define PG8_SCHED __builtin_amdgcn_sched_barrier(0)
    Unit cur, nxt; int ui = 0;
    if (!S.next(0, cur)) return;
    f32x4 acc[2][2][4][2];
#pragma unroll
    for (int a = 0; a < 2; ++a)
#pragma unroll
        for (int b = 0; b < 2; ++b)
#pragma unroll
            for (int m = 0; m < 4; ++m)
#pragma unroll
                for (int n = 0; n < 2; ++n) acc[a][b][m][n] = (f32x4){0.f, 0.f, 0.f, 0.f};
    bf16x8 At[4][2], B0[2][2], B1[2][2];
    const char* cA = (const char*)g.A + (size_t)cur.pm * tstep + cur.koff; const char* cB = (const char*)g.Bt + (size_t)cur.pn * tstep + cur.koff;
    S.a_ready(cur);
    if constexpr (SP2) {
        PG8_STAGE(PG8_SB(0, 0), cB, voffB); PG8_STAGE(PG8_SB(0, 1), cB + hstep, voffB); PG8_STAGE(PG8_SA(0, 0), cA, voffA); PG8_STAGE(PG8_SA(0, 1), cA + hstep, voffA);
        if (wr == 1) PG8_BAR;
        PG8_WAIT_V(2); PG8_BAR;
        PG8_STAGE(PG8_SB(1, 0), cB + kstep, voffB); PG8_STAGE(PG8_SA(1, 0), cA + kstep, voffA); PG8_STAGE(PG8_SB(1, 1), cB + hstep + kstep, voffB);
        PG8_WAIT_V(6); PG8_BAR;
    } else {
        PG8_STAGE(PG8_SB(0, 0), cB, voffB); PG8_STAGE(PG8_SA(0, 0), cA, voffA); PG8_STAGE(PG8_SB(0, 1), cB + hstep, voffB); PG8_STAGE(PG8_SA(0, 1), cA + hstep, voffA);
        if (wr == 1) PG8_BAR;
        PG8_WAIT_V(4); PG8_BAR;
        PG8_STAGE(PG8_SB(1, 0), cB + kstep, voffB); PG8_STAGE(PG8_SA(1, 0), cA + kstep, voffA); PG8_STAGE(PG8_SB(1, 1), cB + hstep + kstep, voffB);
        PG8_WAIT_V(6); PG8_BAR;
    }
    for (;;) {
        const bool has_next = S.next(ui + 1, nxt);
        const char* nA = has_next ? (const char*)g.A + (size_t)nxt.pm * tstep + nxt.koff : cA; const char* nB = has_next ? (const char*)g.Bt + (size_t)nxt.pn * tstep + nxt.koff : cB;
        for (int t = 0; t < nt; t += 2) {
            const bool last = (t == nt - 2);
            const char* a1 = cA + (size_t)(t + 1) * kstep;
            const char* a2 = last ? nA : cA + (size_t)(t + 2) * kstep; const char* b2 = last ? nB : cB + (size_t)(t + 2) * kstep;
            const char* a3 = a2 + kstep; const char* b3 = b2 + kstep;
            if (last && has_next) S.a_ready(nxt);
            if (g.px && t == nt - 8) {
                unsigned zz = 0u; asm volatile("" : "+v"(zz));
                const unsigned tix = ((unsigned)wid << 6) + __builtin_amdgcn_mbcnt_hi(~0u, __builtin_amdgcn_mbcnt_lo(~0u, zz));
                const char* sb = g.px + (size_t)cur.pm * 256 * (size_t)g.pf + (size_t)cur.pn * 512;
                const char* p = sb + ((tix >> 1) * (unsigned)g.pf + (tix & 1u) * 256u);
                __builtin_amdgcn_global_load_lds((const unsigned*)p, (PG8_LAS unsigned*)(lds + STAGE_BYTES + 2048 + wid * 256), 4, 0, 0);
                __builtin_amdgcn_global_load_lds((const unsigned*)(p + 128), (PG8_LAS unsigned*)(lds + STAGE_BYTES + 2048 + wid * 256), 4, 0, 0);
            }
            if constexpr (SP2) {
            PG8_LDB(B0, 0, 0); PG8_LDB(B1, 0, 1); PG8_SCHED; PG8_LDA(At, 0, 0); PG8_STAGE(PG8_SA(1, 1), a1 + hstep, voffA);
            PG8_WAIT_V(8); PG8_WAIT_L(0); PG8_BAR; PG8_MMA(0, 0, At, B0); PG8_MMA(0, 1, At, B1); PG8_BAR; PG8_SCHED;
            PG8_LDA(At, 0, 1); PG8_STAGE(PG8_SB(0, 0), b2, voffB); PG8_STAGE(PG8_SB(0, 1), b2 + hstep, voffB); PG8_STAGE(PG8_SA(0, 0), a2, voffA);
            PG8_WAIT_V(8); PG8_WAIT_L(0); PG8_BAR; PG8_MMA(1, 0, At, B0); PG8_MMA(1, 1, At, B1); PG8_BAR; PG8_SCHED;
            PG8_LDB(B0, 1, 0); PG8_LDB(B1, 1, 1); PG8_SCHED; PG8_LDA(At, 1, 0); PG8_STAGE(PG8_SA(0, 1), a2 + hstep, voffA);
            PG8_WAIT_V(8); PG8_WAIT_L(0); PG8_BAR; PG8_MMA(0, 0, At, B0); PG8_MMA(0, 1, At, B1); PG8_BAR; PG8_SCHED;
            PG8_LDA(At, 1, 1); PG8_STAGE(PG8_SB(1, 0), b3, voffB); PG8_STAGE(PG8_SB(1, 1), b3 + hstep, voffB); PG8_STAGE(PG8_SA(1, 0), a3, voffA);
            PG8_WAIT_V(8); PG8_WAIT_L(0); PG8_BAR; PG8_MMA(1, 0, At, B0); PG8_MMA(1, 1, At, B1); PG8_BAR; PG8_SCHED;
            } else {
            PG8_LDB(B0, 0, 0); PG8_SCHED; PG8_LDA(At, 0, 0); PG8_STAGE(PG8_SA(1, 1), a1 + hstep, voffA);
            PG8_WAIT_L(8); PG8_BAR; PG8_WAIT_L(0); PG8_MMA(0, 0, At, B0); PG8_BAR; PG8_SCHED;
            PG8_LDB(B1, 0, 1); PG8_STAGE(PG8_SB(0, 0), b2, voffB);
            PG8_BAR; PG8_WAIT_L(0); PG8_MMA(0, 1, At, B1); PG8_BAR;
            PG8_LDA(At, 0, 1); PG8_STAGE(PG8_SA(0, 0), a2, voffA);
            PG8_BAR; PG8_WAIT_L(0); PG8_MMA(1, 0, At, B0); PG8_BAR; PG8_SCHED;
            PG8_STAGE(PG8_SB(0, 1), b2 + hstep, voffB);
            PG8_WAIT_V(6); PG8_BAR; PG8_MMA(1, 1, At, B1); PG8_BAR;
            PG8_LDB(B0, 1, 0); PG8_SCHED; PG8_LDA(At, 1, 0); PG8_STAGE(PG8_SA(0, 1), a2 + hstep, voffA);
            PG8_WAIT_L(8); PG8_BAR; PG8_WAIT_L(0); PG8_MMA(0, 0, At, B0); PG8_BAR; PG8_SCHED;
            PG8_LDB(B1, 1, 1); PG8_STAGE(PG8_SB(1, 0), b3, voffB);
            PG8_BAR; PG8_WAIT_L(0); PG8_MMA(0, 1, At, B1); PG8_BAR;
            PG8_LDA(At, 1, 1); PG8_STAGE(PG8_SA(1, 0), a3, voffA);
            PG8_BAR; PG8_WAIT_L(0); PG8_MMA(1, 0, At, B0); PG8_BAR; PG8_SCHED;
            PG8_STAGE(PG8_SB(1, 1), b3 + hstep, voffB);
            PG8_WAIT_V(6); PG8_BAR; PG8_MMA(1, 1, At, B1); PG8_BAR;
            }
        }
        if constexpr (ALIGN_EPI) { if (wr == 0) PG8_BAR; }
        if constexpr (!Epi::AFTER_DRAIN) { E(acc, cur, wr, wc, fr, fq); S.done(cur); }
        if (!has_next) break;
#pragma unroll
        for (int a = 0; a < 2; ++a)
#pragma unroll
            for (int b = 0; b < 2; ++b)
#pragma unroll
                for (int m = 0; m < 4; ++m)
#pragma unroll
                    for (int n = 0; n < 2; ++n) acc[a][b][m][n] = (f32x4){0.f, 0.f, 0.f, 0.f};
        cur = nxt; cA = nA; cB = nB; ++ui;
        if constexpr (ALIGN_EPI) { if (wr == 1) PG8_BAR; }
    }
    PG8_WAIT_V(0);
    if constexpr (!ALIGN_EPI) { if (wr == 0) PG8_BAR; }
    PG8_BAR;
    if constexpr (Epi::AFTER_DRAIN) { E.fused(acc, cur, wr, wc, fr, fq, lds, wid, lane); S.done(cur); }
#undef PG8_SA
#undef PG8_SB
#undef PG8_STAGE
#undef PG8_LDA
#undef PG8_LDB
#undef PG8_MMA
#undef PG8_WAIT_V
#undef PG8_WAIT_L
#undef PG8_BAR
#undef PG8_SCHED
}
}

#define LAS __attribute__((address_space(3)))
typedef unsigned short bf16;
typedef float f32x4 __attribute__((ext_vector_type(4)));
typedef float f32x16 __attribute__((ext_vector_type(16)));
typedef short bf16x8 __attribute__((ext_vector_type(8)));
typedef short s16x4 __attribute__((ext_vector_type(4)));
typedef unsigned u32x4 __attribute__((ext_vector_type(4)));
using pg8::f32x2; using pg8::u32x2; using pg8::pk2;

constexpr int DM = 1024, SEQ = 16384, NBP = 2, MP = NBP * SEQ, DBS = 32, DSQ = 16, MS = DBS * DSQ, MT = MP + MS;
constexpr int NBT = NBP + DBS;
constexpr int INW = 2816, DFF = 4096, NMOD = 6 * DM, NLAYER = 2;
constexpr int CS_ROWS = SEQ + DSQ;
constexpr float LOG2E = 1.4426950408889634f, QSCALE = 0.18033688011112042f  , KSCALE = 0.08838834764831845f  , EPS = 1e-6f;
constexpr int LDH = DFF + 64;
constexpr int NTILE_B = SEQ / 256;

enum { I_XP = 0, I_XS, I_CP, I_CS, I_CK, I_CV, I_SR, I_GMIX, I_GMLP, I_WADA, I_BADA, I_WIN, I_WOUT, I_SINK, I_RELB, I_WUP, I_WDN, I_GFIN };
constexpr size_t O_Y = 0, O_WKP = (size_t)MT * DM, O_WVP = O_WKP + 65536, O_RSP = O_WVP + 65536, O_WKS = O_RSP + 262144, O_WVS = O_WKS + 1048576, O_RSS = O_WVS + 1048576, O_END = O_RSS + 4194304;

constexpr size_t al256(size_t x) { return (x + 255) & ~(size_t)255; }
constexpr size_t WS_CTL = 0, CTL_ZERO_BYTES = 16384;
constexpr size_t WS_BT = 16384;
constexpr size_t WS_MOD = 65536;
constexpr size_t WS_CS = al256(WS_MOD + (size_t)NLAYER * NBT * NMOD * 4);
constexpr size_t WS_WIN = al256(WS_CS + (size_t)CS_ROWS * 64 * 8);
constexpr size_t WS_WOUT = al256(WS_WIN + (size_t)NLAYER * INW * DM * 2);
constexpr size_t WS_WUP = al256(WS_WOUT + (size_t)NLAYER * DM * DM * 2);
constexpr size_t WS_WDN = al256(WS_WUP + (size_t)NLAYER * DFF * DM * 2);
constexpr size_t WS_SS0 = al256(WS_WDN + (size_t)NLAYER * DM * LDH * 2);
constexpr size_t WS_XG = al256(WS_SS0 + (size_t)NLAYER * DBS * 4 * 16384 * 2);
constexpr size_t WS_U = al256(WS_XG + (size_t)MT * DM * 2);
constexpr size_t WS_MIX = al256(WS_U + (size_t)(MT + 64) * INW * 2);
constexpr size_t WS_DT = al256(WS_MIX + (size_t)MT * DM * 2);
constexpr size_t WS_SST = al256(WS_DT + (size_t)NBP * NTILE_B * 4 * 16384 * 4);
constexpr size_t WS_XB = al256(WS_SST + (size_t)NBP * NTILE_B * 4 * 16384 * 2);
constexpr size_t WS_SSP = al256(WS_XB + (size_t)MS * DM * 2);
constexpr size_t WS_SHM = al256(WS_SSP + (size_t)2 * MT * 4);
constexpr size_t WS_GS = al256(WS_SHM + (size_t)NLAYER * 2 * 256 * DM * 2);
constexpr size_t WS_GSI = al256(WS_GS + (size_t)(NLAYER * 2 + 1) * NBT * DM * 4);
constexpr size_t WS_C1 = al256(WS_GSI + (size_t)(NLAYER * 2) * NBT * DM * 4);
constexpr size_t WS_C2 = al256(WS_C1 + (size_t)NLAYER * NBT * INW * 4);
constexpr int KS2 = 4, KS4 = 16;
constexpr size_t WS_Y2 = al256(WS_C2 + (size_t)NLAYER * NBT * DFF * 4);
constexpr size_t WS_Y4 = al256(WS_Y2 + (size_t)KS2 * MS * DM * 4);
constexpr size_t WS_END = al256(WS_Y4 + (size_t)KS4 * MS * DM * 4);
constexpr size_t WS_HID = WS_U;
static_assert(WS_HID + (size_t)MT * LDH * 2 <= WS_SST && WS_END <= (size_t)512 * 1024 * 1024, "HID overlay fits; the map stays under 512 MiB");

constexpr int LDS_BYTES = 147456;
constexpr int MISC_OFF = LDS_BYTES - 256;

__device__ __forceinline__ int row_bidx(int r) { return r < MP ? (r >> 14) : NBP + ((r - MP) >> 4); }
__device__ __forceinline__ int row_csidx(int r) { return r < MP ? (r & (SEQ - 1)) : SEQ + (r & 15); }
__device__ __forceinline__ float bf2f(unsigned short b) { return __uint_as_float(((unsigned)b) << 16); }
__device__ __forceinline__ float wave_sum(float v) {
#pragma unroll
    for (int o = 1; o < 64; o <<= 1) v += __shfl_xor(v, o);
    return v;
}
__device__ __forceinline__ int crow(int r, int h) { return (r & 3) + 8 * (r >> 2) + 4 * h; }
__device__ __forceinline__ float log2gamma(int h) { return h == 0 ? -0.04580368961312479f : h == 1 ? -0.02272007650008353f : h == 2 ? -0.011315313227834146f : -0.005646563141142063f; }
__device__ __forceinline__ int rel_bucket(int rel) {
    const int n = rel < 0 ? -rel : rel; const int base = rel > 0 ? 16 : 0;
    int v;
    if (n < 8) v = n; else if (n < 12) v = 8; else if (n < 16) v = 9; else if (n < 23) v = 10; else if (n < 32) v = 11; else if (n < 46) v = 12; else if (n < 64) v = 13; else if (n < 91) v = 14; else v = 15;
    return base + v;
}
#define MFMA32(a, b, c) __builtin_amdgcn_mfma_f32_32x32x16_bf16((a), (b), (c), 0, 0, 0)

__device__ __forceinline__ float row_rstd(const float* ss, int row) { return __builtin_amdgcn_rsqf(ss[row] * (1.0f / DM) + EPS); }
struct EpiG1 {
    bf16* U; const float* cs; float* wkp; float* wvp; float* wks; float* wvs; const float* ss; const float* cv;
    template <bool UNI> __device__ __forceinline__ void run(const pg8::f32x4 (&acc)[2][2][4][2], const pg8::Unit& u, int wr, int wc, int fr, int fq) const {
        const int pn = u.pn, rowb = u.pm * 256 + wr * 64 + fr, colq = pn * 256 + wc * 32 + 8 * fq;
        pg8::f32x4 cu[2][2];
        if (UNI) { const float* cb = cv + (size_t)(u.pm >> 6) * INW + colq;
#pragma unroll
            for (int bj = 0; bj < 2; ++bj) { cu[bj][0] = *(const pg8::f32x4*)(cb + bj * 128); cu[bj][1] = *(const pg8::f32x4*)(cb + bj * 128 + 4); } }
        if (pn >= 3 && pn <= 6) {
            const float ksc = pn >= 5 ? KSCALE : 1.f; const int g = 4 * wc + fq;
#pragma unroll
            for (int ai = 0; ai < 2; ++ai)
#pragma unroll
                for (int m = 0; m < 4; ++m) {
                    const int row = rowb + ai * 128 + m * 16;
                    const float rs = row_rstd(ss, row); const float* cb = cv + (size_t)row_bidx(row) * INW + colq;
                    const pg8::f32x4* cp = (const pg8::f32x4*)(cs + ((size_t)row_csidx(row) * 64 + 4 * g) * 2);
                    const pg8::f32x4 c01 = cp[0], c23 = cp[1];
                    const float co[4] = {c01.x, c01.z, c23.x, c23.z}, si[4] = {c01.y, c01.w, c23.y, c23.w};
#pragma unroll
                    for (int bj = 0; bj < 2; ++bj) {
                        const pg8::f32x4 b0 = UNI ? cu[bj][0] : *(const pg8::f32x4*)(cb + bj * 128), b1 = UNI ? cu[bj][1] : *(const pg8::f32x4*)(cb + bj * 128 + 4);
                        const pg8::f32x4 x1 = acc[ai][bj][m][0] * rs + b0, x2 = acc[ai][bj][m][1] * rs + b1; float o1[4], o2[4];
#pragma unroll
                        for (int j = 0; j < 4; ++j) { o1[j] = (x1[j] * co[j] - x2[j] * si[j]) * ksc; o2[j] = (x2[j] * co[j] + x1[j] * si[j]) * ksc; }
                        bf16* p = U + (size_t)row * INW + pn * 256 + bj * 128 + 4 * g;
                        u32x2 w1, w2; w1.x = pk2(o1[0], o1[1]); w1.y = pk2(o1[2], o1[3]); w2.x = pk2(o2[0], o2[1]); w2.y = pk2(o2[2], o2[3]);
                        { const auto r0 = __builtin_amdgcn_permlane16_swap(w1.x, w2.x, false, false), r1 = __builtin_amdgcn_permlane16_swap(w1.y, w2.y, false, false);
                          u32x4 w; w.x = r0[0]; w.y = r1[0]; w.z = r0[1]; w.w = r1[1];
                          *(u32x4*)(p + ((fq & 1) ? 60 : 0)) = w; }
                    }
                }
        } else {
            const float sc = pn < 2 ? QSCALE : 1.f;
            const bool win = pn == 2 && (u.pm >= MP / 256 || (u.pm & (SEQ / 256 - 1)) == SEQ / 256 - 1);
            if (pn >= 9) plain<UNI, 1>(acc, u, wr, wc, fr, fq, cu, sc); else if (win) plain<UNI, 2>(acc, u, wr, wc, fr, fq, cu, sc); else plain<UNI, 0>(acc, u, wr, wc, fr, fq, cu, sc);
        }
    }
    template <bool UNI, int MODE> __device__ __forceinline__ void plain(const pg8::f32x4 (&acc)[2][2][4][2], const pg8::Unit& u, int wr, int wc, int fr, int fq, const pg8::f32x4 (&cu)[2][2], float sc) const {
        const int pn = u.pn, rowb = u.pm * 256 + wr * 64 + fr, colq = pn * 256 + wc * 32 + 8 * fq;
#pragma unroll
        for (int ai = 0; ai < 2; ++ai)
#pragma unroll
            for (int m = 0; m < 4; ++m) {
                const int row = rowb + ai * 128 + m * 16;
                const float rs = row_rstd(ss, row); const float* cb = cv + (size_t)row_bidx(row) * INW + colq;
#pragma unroll
                for (int bj = 0; bj < 2; ++bj) {
                    const pg8::f32x4 b0 = UNI ? cu[bj][0] : *(const pg8::f32x4*)(cb + bj * 128), b1 = UNI ? cu[bj][1] : *(const pg8::f32x4*)(cb + bj * 128 + 4);
                    const pg8::f32x4 a0 = acc[ai][bj][m][0] * rs + b0, a1 = acc[ai][bj][m][1] * rs + b1;
                    pg8::f32x4 v0 = a0 * sc, v1 = a1 * sc;
                    if (MODE == 1) {
#pragma unroll
                        for (int j = 0; j < 4; ++j) { v0[j] = v0[j] * __builtin_amdgcn_rcpf(1.f + __expf(-v0[j])); v1[j] = v1[j] * __builtin_amdgcn_rcpf(1.f + __expf(-v1[j])); }
                    }
                    u32x4 w; w.x = pk2(v0[0], v0[1]); w.y = pk2(v0[2], v0[3]); w.z = pk2(v1[0], v1[1]); w.w = pk2(v1[2], v1[3]);
                    *(u32x4*)(U + (size_t)row * INW + colq + bj * 128) = w;
                    if (MODE == 2) {
                        float* dst = nullptr;
                        if (row < MP) { const int s = row & (SEQ - 1); if (s >= SEQ - 128) dst = (bj ? wvp : wkp) + ((size_t)((row >> 14) * 128 + (s - (SEQ - 128))) * 128 + wc * 32 + 8 * fq); }
                        else { const int jj = (row - MP) >> 4, i = row & 15; dst = (bj ? wvs : wks) + ((size_t)(jj * 128 + 112 + i) * 128 + wc * 32 + 8 * fq); }
                        if (dst) { *(pg8::f32x4*)dst = a0; *(pg8::f32x4*)(dst + 4) = a1; }
                    }
                }
            }
    }
};
struct EpiRes {
    bf16* XG; float* ss_acc; float* ss_zero; const float* modl; int ga_off; const float* gsn; const float* gip;
    template <bool UNI> __device__ __forceinline__ void run(const pg8::f32x4 (&acc)[2][2][4][2], const pg8::Unit& u, int wr, int wc, int fr, int fq) const {
        const int rowb = u.pm * 256 + wr * 64 + fr, colb = u.pn * 256 + wc * 32 + 8 * fq;
        pg8::f32x4 gu[2][2], su[2][2], iu[2][2];
        if (UNI) { const float* ga = modl + (size_t)(u.pm >> 6) * NMOD + ga_off + colb; const float* gs = gsn + (size_t)(u.pm >> 6) * DM + colb; const float* gi = gip + (size_t)(u.pm >> 6) * DM + colb;
#pragma unroll
            for (int bj = 0; bj < 2; ++bj) { gu[bj][0] = *(const pg8::f32x4*)(ga + bj * 128); gu[bj][1] = *(const pg8::f32x4*)(ga + bj * 128 + 4); su[bj][0] = *(const pg8::f32x4*)(gs + bj * 128); su[bj][1] = *(const pg8::f32x4*)(gs + bj * 128 + 4);
                iu[bj][0] = *(const pg8::f32x4*)(gi + bj * 128); iu[bj][1] = *(const pg8::f32x4*)(gi + bj * 128 + 4); } }
#pragma unroll
        for (int ai = 0; ai < 2; ++ai)
#pragma unroll
            for (int m = 0; m < 4; ++m) {
                const int row = rowb + ai * 128 + m * 16, b = row_bidx(row);
                const float* ga = modl + (size_t)b * NMOD + ga_off + colb; const float* gs = gsn + (size_t)b * DM + colb; const float* gi = gip + (size_t)b * DM + colb;
                float ssq = 0.f;
#pragma unroll
                for (int bj = 0; bj < 2; ++bj) {
                    bf16* xp = XG + (size_t)row * DM + colb + bj * 128;
                    const u32x4 xw = *(const u32x4*)xp;
                    const pg8::f32x4 g0 = UNI ? gu[bj][0] : *(const pg8::f32x4*)(ga + bj * 128), g1 = UNI ? gu[bj][1] : *(const pg8::f32x4*)(ga + bj * 128 + 4);
                    const pg8::f32x4 s0 = UNI ? su[bj][0] : *(const pg8::f32x4*)(gs + bj * 128), s1 = UNI ? su[bj][1] : *(const pg8::f32x4*)(gs + bj * 128 + 4);
                    const pg8::f32x4 i0 = UNI ? iu[bj][0] : *(const pg8::f32x4*)(gi + bj * 128), i1 = UNI ? iu[bj][1] : *(const pg8::f32x4*)(gi + bj * 128 + 4);
                    pg8::f32x4 x0, x1;
                    x0.x = __uint_as_float(xw.x << 16); x0.y = __uint_as_float(xw.x & 0xffff0000u); x0.z = __uint_as_float(xw.y << 16); x0.w = __uint_as_float(xw.y & 0xffff0000u);
                    x1.x = __uint_as_float(xw.z << 16); x1.y = __uint_as_float(xw.z & 0xffff0000u); x1.z = __uint_as_float(xw.w << 16); x1.w = __uint_as_float(xw.w & 0xffff0000u);
                    x0 = x0 * i0 + g0 * acc[ai][bj][m][0]; x1 = x1 * i1 + g1 * acc[ai][bj][m][1];
                    ssq += ((x0.x * x0.x + x0.y * x0.y) + (x0.z * x0.z + x0.w * x0.w)) + ((x1.x * x1.x + x1.y * x1.y) + (x1.z * x1.z + x1.w * x1.w));
                    x0 = x0 * s0; x1 = x1 * s1;
                    u32x4 w; w.x = pk2(x0.x, x0.y); w.y = pk2(x0.z, x0.w); w.z = pk2(x1.x, x1.y); w.w = pk2(x1.z, x1.w);
                    *(u32x4*)xp = w;
                }
                ssq += __shfl_xor(ssq, 16); ssq += __shfl_xor(ssq, 32);
                if (fq == 0) { atomicAdd(ss_acc + row, ssq); if (u.pn == 0 && wc == 0) ss_zero[row] = 0.f; }
            }
    }
};
struct EpiHid {
    bf16* H; const float* ss; const float* cv;
    template <bool UNI> __device__ __forceinline__ void run(const pg8::f32x4 (&acc)[2][2][4][2], const pg8::Unit& u, int wr, int wc, int fr, int fq) const {
        const int rowb = u.pm * 256 + wr * 64 + fr, colb = u.pn * 256 + wc * 32 + 8 * fq;
        pg8::f32x4 cu[2][2];
        if (UNI) { const float* cb = cv + (size_t)(u.pm >> 6) * DFF + colb;
#pragma unroll
            for (int bj = 0; bj < 2; ++bj) { cu[bj][0] = *(const pg8::f32x4*)(cb + bj * 128); cu[bj][1] = *(const pg8::f32x4*)(cb + bj * 128 + 4); } }
#pragma unroll
        for (int ai = 0; ai < 2; ++ai)
#pragma unroll
            for (int m = 0; m < 4; ++m) {
                const int row = rowb + ai * 128 + m * 16;
                const float rs = row_rstd(ss, row); const float* cb = cv + (size_t)row_bidx(row) * DFF + colb;
                bf16* rp = H + (size_t)row * LDH + colb;
#pragma unroll
                for (int bj = 0; bj < 2; ++bj) {
                    const pg8::f32x4 b0 = UNI ? cu[bj][0] : *(const pg8::f32x4*)(cb + bj * 128), b1 = UNI ? cu[bj][1] : *(const pg8::f32x4*)(cb + bj * 128 + 4);
                    pg8::f32x4 v0 = acc[ai][bj][m][0] * rs + b0, v1 = acc[ai][bj][m][1] * rs + b1;
#pragma unroll
                    for (int j = 0; j < 4; ++j) { const float a = fmaxf(v0[j], 0.f), b = fmaxf(v1[j], 0.f); v0[j] = a * a; v1[j] = b * b; }
                    u32x4 w; w.x = pk2(v0[0], v0[1]); w.y = pk2(v0[2], v0[3]); w.z = pk2(v1[0], v1[1]); w.w = pk2(v1[2], v1[3]);
                    *(u32x4*)(rp + bj * 128) = w;
                }
            }
    }
};
struct EpiCvec {
    float* out; int ld;
    __device__ __forceinline__ void run(const pg8::f32x4 (&acc)[2][2][4][2], const pg8::Unit& u, int wr, int wc, int fr, int fq) const {
        if (wr != 0) return;
        const int colb = u.pn * 256 + wc * 32 + 8 * fq;
#pragma unroll
        for (int m = 0; m < 3; ++m) { const int row = m * 16 + fr;
            if (row < NBT) {
#pragma unroll
                for (int bj = 0; bj < 2; ++bj) { *(pg8::f32x4*)(out + (size_t)row * ld + colb + bj * 128) = acc[0][bj][m][0]; *(pg8::f32x4*)(out + (size_t)row * ld + colb + bj * 128 + 4) = acc[0][bj][m][1]; } } }
    }
};
struct EpiAcc {
    float* Y; int kbytes;
    __device__ __forceinline__ void run(const pg8::f32x4 (&acc)[2][2][4][2], const pg8::Unit& u, int wr, int wc, int fr, int fq) const {
        const int rowb = u.pm * 256 - MP + wr * 64 + fr, colb = u.pn * 256 + wc * 32 + 8 * fq;
        float* Ys = Y + (size_t)(u.koff / kbytes) * MS * DM;
#pragma unroll
        for (int ai = 0; ai < 2; ++ai)
#pragma unroll
            for (int m = 0; m < 4; ++m) { float* yp = Ys + (size_t)(rowb + ai * 128 + m * 16) * DM + colb;
#pragma unroll
                for (int bj = 0; bj < 2; ++bj) { *(pg8::f32x4*)(yp + bj * 128) = acc[ai][bj][m][0]; *(pg8::f32x4*)(yp + bj * 128 + 4) = acc[ai][bj][m][1]; } }
    }
};
struct EpiAll {
    static constexpr bool AFTER_DRAIN = false;
    int kind, l; unsigned char* ws; float* out;
    __device__ __forceinline__ bool perm() const { return true; }
    __device__ __forceinline__ void operator()(const pg8::f32x4 (&acc)[2][2][4][2], const pg8::Unit& u, int wr, int wc, int fr, int fq) const {
        const bool uni = u.pm < MP / 256;
        float* const ssa = (float*)(ws + WS_SSP); float* const ssb = ssa + MT;
        if (kind == 0) {
            const EpiG1 e{(bf16*)(ws + WS_U), (const float*)(ws + WS_CS), out + O_WKP + (size_t)l * 32768, out + O_WVP + (size_t)l * 32768, out + O_WKS + (size_t)l * 524288, out + O_WVS + (size_t)l * 524288, ssb, (const float*)(ws + WS_C1) + (size_t)l * NBT * INW};
            if (uni) e.run<true>(acc, u, wr, wc, fr, fq); else e.run<false>(acc, u, wr, wc, fr, fq);
        } else if (kind == 1) {
            const EpiHid e{(bf16*)(ws + WS_HID), ssa, (const float*)(ws + WS_C2) + (size_t)l * NBT * DFF};
            if (uni) e.run<true>(acc, u, wr, wc, fr, fq); else e.run<false>(acc, u, wr, wc, fr, fq);
        } else if (kind == 2 || kind == 3) {
            const bool o = kind == 2;
            const EpiRes e{(bf16*)(ws + WS_XG), o ? ssa : ssb, o ? ssb : ssa, (const float*)(ws + WS_MOD) + (size_t)l * NBT * NMOD, (o ? 2 : 5) * DM, (const float*)(ws + WS_GS) + (size_t)(o ? 2 * l + 1 : 2 * l + 2) * NBT * DM, (const float*)(ws + WS_GSI) + (size_t)(o ? 2 * l : 2 * l + 1) * NBT * DM};
            if (uni) e.run<true>(acc, u, wr, wc, fr, fq); else e.run<false>(acc, u, wr, wc, fr, fq);
        } else if (kind == 5 || kind == 6) {
            const EpiAcc e{(float*)(ws + (kind == 5 ? WS_Y2 : WS_Y4)), kind == 5 ? 2 * DM / KS2 : 2 * DFF / KS4};
            e.run(acc, u, wr, wc, fr, fq);
        } else {
            const int sl = l >> 1; const bool cup = (l & 1) != 0;
            const EpiCvec e{cup ? (float*)(ws + WS_C2) + (size_t)sl * NBT * DFF : (float*)(ws + WS_C1) + (size_t)sl * NBT * INW, cup ? DFF : INW};
            e.run(acc, u, wr, wc, fr, fq);
        }
    }
};

struct Params { const float* in[18]; float* out; unsigned char* ws; int ph_lo, ph_hi, coop, pad; };
struct Ctx { LAS unsigned char* lds; int tid, lane, wave, vcu, G; };
#define LDS_WAIT() asm volatile("s_waitcnt lgkmcnt(0)" ::: "memory")

__device__ __constant__ const double INVF[64] = {1.0, 0.8659643233600653, 0.7498942093324559, 0.6493816315762113, 0.5623413251903491, 0.4869675251658631, 0.4216965034285822, 0.3651741272548377, 0.31622776601683794, 0.27384196342643613, 0.23713737056616552, 0.2053525026457146, 0.1778279410038923, 0.1539926526059492, 0.1333521432163324, 0.11547819846894582, 0.1, 0.08659643233600653, 0.07498942093324558, 0.06493816315762113, 0.05623413251903491, 0.04869675251658631, 0.042169650342858224, 0.03651741272548377, 0.03162277660168379, 0.027384196342643614, 0.023713737056616554, 0.02053525026457146, 0.01778279410038923, 0.01539926526059492, 0.01333521432163324, 0.011547819846894581, 0.01, 0.008659643233600654, 0.007498942093324558, 0.006493816315762113, 0.005623413251903491, 0.004869675251658631, 0.004216965034285823, 0.003651741272548377, 0.0031622776601683794, 0.0027384196342643613, 0.0023713737056616554, 0.002053525026457146, 0.0017782794100389228, 0.001539926526059492, 0.001333521432163324, 0.0011547819846894581, 0.001, 0.0008659643233600654, 0.0007498942093324559, 0.0006493816315762113, 0.0005623413251903491, 0.0004869675251658631, 0.00042169650342858224, 0.0003651741272548377, 0.00031622776601683794, 0.0002738419634264361, 0.00023713737056616554, 0.0002053525026457146, 0.00017782794100389227, 0.0001539926526059492, 0.0001333521432163324, 0.00011547819846894582};

template <bool ROT> __device__ __forceinline__ void p0_transpose_item(const float* W, int K, int N, bf16* WT, int ldo, LAS float* scr, int item, int lane) {
    const int nblk = N / 32, kb = item / nblk, nb = item % nblk, k0 = 64 * kb, n0 = 32 * nb;
#pragma unroll 8
    for (int i = 0; i < 32; ++i) { const int kk = 2 * i + (lane >> 5); scr[kk * 33 + (lane & 31)] = W[(size_t)(k0 + kk) * N + n0 + (lane & 31)]; }
    LDS_WAIT(); asm volatile("" ::: "memory");
    const int c = lane & 7;
#pragma unroll
    for (int j = 0; j < 4; ++j) { const int n = (lane >> 3) + 8 * j; const LAS float* s = scr + (8 * c) * 33 + n;
        u32x4 o; o.x = pk2(s[0 * 33], s[1 * 33]); o.y = pk2(s[2 * 33], s[3 * 33]); o.z = pk2(s[4 * 33], s[5 * 33]); o.w = pk2(s[6 * 33], s[7 * 33]);
        int nd = n0 + n;
        if (ROT && nd >= 768 && nd < 1792) { const int d = nd & 127; nd = (nd & ~127) + 8 * ((d & 63) >> 2) + 4 * (d >> 6) + (d & 3); }
        *(u32x4*)(WT + (size_t)nd * ldo + k0 + 8 * c) = o; }
    LDS_WAIT(); asm volatile("" ::: "memory");
}

constexpr int ADA_TROW = 2064, ADA_TLO = NBT * ADA_TROW;
static_assert(2 * ADA_TLO <= MISC_OFF, "adaLN LDS map");
__device__ __forceinline__ void ada_item(const Ctx& C, const float* W, int eg, const float* bias, float* out, bf16* shm) {
    LAS unsigned char* lds = C.lds;
    const int w = C.wave, l31 = C.lane & 31, h = C.lane >> 5;
    f32x16 acc[2][2];
#pragma unroll
    for (int mt = 0; mt < 2; ++mt)
#pragma unroll
        for (int nt = 0; nt < 2; ++nt)
#pragma unroll
            for (int r = 0; r < 16; ++r) acc[mt][nt][r] = 0.f;
    const float* wp = W + (size_t)(128 * w + 8 * h) * NMOD + eg * 64 + l31;
    const int ra0 = l31 * ADA_TROW, ra1 = ((32 + l31) < NBT ? (32 + l31) : NBT - 1) * ADA_TROW;
#pragma unroll 1
    for (int hf = 0; hf < 2; ++hf) {
        float wv[4][2][8];
#pragma unroll
        for (int s = 0; s < 4; ++s)
#pragma unroll
            for (int nt = 0; nt < 2; ++nt)
#pragma unroll
                for (int j = 0; j < 8; ++j) wv[s][nt][j] = wp[(size_t)(64 * hf + 16 * s + j) * NMOD + 32 * nt];
#pragma unroll
        for (int s = 0; s < 4; ++s) {
            const int kb = (128 * w + 64 * hf + 16 * s + 8 * h) * 2;
            bf16x8 ah[2], al[2], bh[2], bl[2];
            ah[0] = *(const LAS bf16x8*)(lds + ra0 + kb); al[0] = *(const LAS bf16x8*)(lds + ADA_TLO + ra0 + kb);
            ah[1] = *(const LAS bf16x8*)(lds + ra1 + kb); al[1] = *(const LAS bf16x8*)(lds + ADA_TLO + ra1 + kb);
#pragma unroll
            for (int nt = 0; nt < 2; ++nt) { u32x4 ph, pl;
                unsigned* phw = (unsigned*)&ph; unsigned* plw = (unsigned*)&pl;
#pragma unroll
                for (int jj = 0; jj < 4; ++jj) { const float a = wv[s][nt][2 * jj], bq = wv[s][nt][2 * jj + 1]; const unsigned hh = pk2(a, bq);
                    phw[jj] = hh; plw[jj] = pk2(a - __uint_as_float(hh << 16), bq - __uint_as_float(hh & 0xffff0000u)); }
                bh[nt] = __builtin_bit_cast(bf16x8, ph); bl[nt] = __builtin_bit_cast(bf16x8, pl); }
#pragma unroll
            for (int mt = 0; mt < 2; ++mt)
#pragma unroll
                for (int nt = 0; nt < 2; ++nt) { acc[mt][nt] = MFMA32(ah[mt], bh[nt], acc[mt][nt]); acc[mt][nt] = MFMA32(ah[mt], bl[nt], acc[mt][nt]); acc[mt][nt] = MFMA32(al[mt], bh[nt], acc[mt][nt]); }
        }
    }
    __syncthreads();
    LAS float* red = (LAS float*)lds;
#pragma unroll
    for (int mt = 0; mt < 2; ++mt)
#pragma unroll
        for (int nt = 0; nt < 2; ++nt)
#pragma unroll
            for (int r = 0; r < 16; ++r) { const int b = 32 * mt + crow(r, h); if (b < NBT) red[(w * NBT + b) * 64 + 32 * nt + l31] = acc[mt][nt][r]; }
    __syncthreads();
    for (int o = C.tid; o < NBT * 64; o += 512) { const int b = o >> 6, ln = o & 63; float s = bias[eg * 64 + ln];
#pragma unroll
        for (int ww = 0; ww < 8; ++ww) s += red[(ww * NBT + b) * 64 + ln];
        const int nd = eg * 64 + ln;
        out[(size_t)b * NMOD + nd] = s;
        const int kind = nd < DM ? 0 : ((nd >= 3 * DM && nd < 4 * DM) ? 1 : -1);
        if (kind >= 0) shm[((size_t)kind * 256 + b) * DM + (nd & (DM - 1))] = (bf16)(pk2(s, 0.f) & 0xffff); }
    __syncthreads();
}

__device__ __forceinline__ void phase_prologue(const Ctx& C, const Params& P) {
    unsigned char* ws = P.ws;
    if (P.pad & 1) {
        LAS float* scr = (LAS float*)(C.lds + C.wave * 16384);
        const int gw = C.vcu * 8 + C.wave, NGW = C.G * 8;
        constexpr int I_IN = (DM / 64) * (INW / 32), I_O = (DM / 64) * (DM / 32), I_U = (DM / 64) * (DFF / 32), I_D = (DFF / 64) * (DM / 32), I_L = I_IN + I_O + I_U + I_D;
        constexpr int I_S = NLAYER * DBS * 4 * 8;
        for (int it = gw; it < NLAYER * I_L + I_S; it += NGW) {
            if (it < NLAYER * I_L) {
                const int l = it / I_L; int r = it % I_L;
                if (r < I_IN) { p0_transpose_item<true>(P.in[I_WIN] + (size_t)l * DM * INW, DM, INW, (bf16*)(ws + WS_WIN) + (size_t)l * INW * DM, DM, scr, r, C.lane); continue; } r -= I_IN;
                if (r < I_O) { p0_transpose_item<false>(P.in[I_WOUT] + (size_t)l * DM * DM, DM, DM, (bf16*)(ws + WS_WOUT) + (size_t)l * DM * DM, DM, scr, r, C.lane); continue; } r -= I_O;
                if (r < I_U) { p0_transpose_item<false>(P.in[I_WUP] + (size_t)l * DM * DFF, DM, DFF, (bf16*)(ws + WS_WUP) + (size_t)l * DFF * DM, DM, scr, r, C.lane); continue; } r -= I_U;
                p0_transpose_item<false>(P.in[I_WDN] + (size_t)l * DFF * DM, DFF, DM, (bf16*)(ws + WS_WDN) + (size_t)l * DM * LDH, LDH, scr, r, C.lane);
            } else {
                const int r = it - NLAYER * I_L, mtx = r >> 3;
                p0_transpose_item<false>(P.in[I_SR] + (size_t)mtx * 16384, 128, 128, (bf16*)(ws + WS_SS0) + (size_t)mtx * 16384, 128, scr, r & 7, C.lane);
            }
        }
    }
    if (P.pad & 2) {
        float* cs = (float*)(ws + WS_CS);
        for (int i = C.vcu * 512 + C.tid; i < CS_ROWS * 64; i += C.G * 512) {
            const int r = i >> 6, d = i & 63; const int pos = r < SEQ ? r : 4096 + (r - SEQ);
            const double rev = (double)pos * INVF[d] * 0.15915494309189535; const float fr = (float)(rev - __builtin_rint(rev));
            f32x2 o; o.x = __builtin_amdgcn_cosf(fr); o.y = __builtin_amdgcn_sinf(fr);
            *(f32x2*)(cs + (size_t)i * 2) = o;
        }
    }
    for (int i = C.vcu * 512 + C.tid; i < 2048; i += C.G * 512) { const int idx = i & 255, hg = i >> 8;
        ((float*)(ws + WS_BT))[i] = idx < 255 ? P.in[I_RELB][rel_bucket(idx - 191) * 8 + hg] * LOG2E : 0.f; }
    {
        constexpr int NV = NLAYER * DBS * 112 * 32;
        for (int i = C.vcu * 512 + C.tid; i < 2 * NV; i += C.G * 512) {
            const int t = i >= NV, q = t ? i - NV : i; const int lj = q / (112 * 32), rem = q % (112 * 32);
            const f32x4 v = *(const f32x4*)(P.in[t ? I_CV : I_CK] + (size_t)lj * 16384 + 16 * 128 + (size_t)rem * 4);
            *(f32x4*)(P.out + (t ? O_WVS : O_WKS) + (size_t)lj * 16384 + (size_t)rem * 4) = v;
        }
    }
    __syncthreads();
    if (P.pad & 4) for (int it = C.vcu; it < NLAYER * (NMOD / 64); it += C.G) {
        const int l = it / (NMOD / 64), eg = it % (NMOD / 64);
        for (int i = C.tid; i < NBT * DM / 2; i += 512) { const int b = i >> 9, k = (i & 511) * 2;
            const f32x2 c = *(const f32x2*)(b < NBP ? P.in[I_CP] + b * DM + k : P.in[I_CS] + (b - NBP) * DM + k);
            const float s0 = c.x / (1.f + __expf(-c.x)), s1 = c.y / (1.f + __expf(-c.y)); const unsigned hh = pk2(s0, s1);
            *(LAS unsigned*)(C.lds + b * ADA_TROW + k * 2) = hh;
            *(LAS unsigned*)(C.lds + ADA_TLO + b * ADA_TROW + k * 2) = pk2(s0 - __uint_as_float(hh << 16), s1 - __uint_as_float(hh & 0xffff0000u)); }
        __syncthreads();
        ada_item(C, P.in[I_WADA] + (size_t)l * DM * NMOD, eg, P.in[I_BADA] + (size_t)l * NMOD, (float*)(ws + WS_MOD) + (size_t)l * NBT * NMOD, (bf16*)(ws + WS_SHM) + (size_t)l * 2 * 256 * DM);
    }
}
constexpr int NCVEC = INW / 256;
__device__ __forceinline__ void phase_prologue2(const Ctx& C, const Params& P) {
    unsigned char* ws = P.ws;
    const float* mod = (const float*)(ws + WS_MOD);
    {
        float* GS = (float*)(ws + WS_GS);
        for (int i = C.vcu * 512 + C.tid; i < (NLAYER * 2 + 1) * NBT * DM; i += C.G * 512) {
            const int c = i & (DM - 1), b = (i >> 10) % NBT, lk = i / (NBT * DM);
            float v;
            if (lk == NLAYER * 2) v = P.in[I_GFIN][c];
            else { const int l = lk >> 1, kind = lk & 1; v = P.in[kind ? I_GMLP : I_GMIX][l * DM + c] * (1.0f + mod[((size_t)l * NBT + b) * NMOD + (kind ? 4 : 1) * DM + c]); }
            GS[i] = v;
            if (lk < NLAYER * 2) ((float*)(ws + WS_GSI))[i] = 1.0f / v;
        }
    }
    {
        const int bx = blockIdx.x, G = C.G, ncv = G > NCVEC ? NCVEC : 0;
        const long tot = ncv + 3L * (G - ncv);
        const long p0 = bx < ncv ? bx : ncv + 3L * (bx - ncv), p1 = (bx + 1) <= ncv ? (bx + 1) : ncv + 3L * (bx + 1 - ncv);
        const int r0 = (int)((long)MT * p0 / tot), r1 = (int)((long)MT * p1 / tot);
        bf16* XG = (bf16*)(ws + WS_XG); bf16* XB = (bf16*)(ws + WS_XB) - (size_t)MP * DM;   float* ssa = (float*)(ws + WS_SSP); float* ssb = ssa + MT;
        for (int r = r0 + C.wave; r < r1; r += 8) {
            const float* xr = r < MP ? P.in[I_XP] + (size_t)r * DM : P.in[I_XS] + (size_t)(r - MP) * DM;
            const float* sc = mod + (size_t)row_bidx(r) * NMOD + DM;
            float s = 0.f;
#pragma unroll
            for (int j = 0; j < 4; ++j) { const int c = 4 * C.lane + 256 * j; const f32x4 v = *(const f32x4*)(xr + c); s += (v.x * v.x + v.y * v.y) + (v.z * v.z + v.w * v.w);
                const f32x4 gv = *(const f32x4*)(P.in[I_GMIX] + c), sv = *(const f32x4*)(sc + c); const f32x4 h = v * gv * (sv + 1.0f);
                u32x2 w; w.x = pk2(h.x, h.y); w.y = pk2(h.z, h.w); *(u32x2*)(XG + (size_t)r * DM + c) = w;
                if (r >= MP) { w.x = pk2(v.x, v.y); w.y = pk2(v.z, v.w); *(u32x2*)(XB + (size_t)r * DM + c) = w; } }
            s = wave_sum(s);
            if (C.lane == 0) { ssb[r] = s; ssa[r] = 0.f; }
        }
    }
}

__device__ __forceinline__ void phase_final(const Ctx& C, const bf16* XG, const float* ss, float* y) {
    const int gw = C.vcu * 8 + C.wave, NGW = C.G * 8;
    for (int r = gw; r < MT; r += NGW) {
        const float rs = row_rstd(ss, r);
#pragma unroll
        for (int j = 0; j < 2; ++j) { const int c = 8 * C.lane + 512 * j;
            const u32x4 xw = *(const u32x4*)(XG + (size_t)r * DM + c);
            f32x4 x0, x1;
            x0.x = __uint_as_float(xw.x << 16); x0.y = __uint_as_float(xw.x & 0xffff0000u); x0.z = __uint_as_float(xw.y << 16); x0.w = __uint_as_float(xw.y & 0xffff0000u);
            x1.x = __uint_as_float(xw.z << 16); x1.y = __uint_as_float(xw.z & 0xffff0000u); x1.z = __uint_as_float(xw.w << 16); x1.w = __uint_as_float(xw.w & 0xffff0000u);
            *(f32x4*)(y + (size_t)r * DM + c) = x0 * rs; *(f32x4*)(y + (size_t)r * DM + c + 4) = x1 * rs; }
    }
}
template <int KS> __device__ __forceinline__ void phase_fz(const Ctx& C, bf16* XB, bf16* XG, const float* Y, float* ss, const float* modl, int ga_off, const float* gsn) {
    const int gw = C.vcu * 8 + C.wave, NGW = C.G * 8;
    for (int rr = gw; rr < MS; rr += NGW) {
        const int r = MP + rr, b = row_bidx(r); float s = 0.f;
#pragma unroll
        for (int j = 0; j < 2; ++j) { const int c = 8 * C.lane + 512 * j;
            const u32x4 xw = *(const u32x4*)(XB + (size_t)r * DM + c);
            f32x4 y0 = {0.f, 0.f, 0.f, 0.f}, y1 = {0.f, 0.f, 0.f, 0.f};
#pragma unroll
            for (int q = 0; q < KS; ++q) { const f32x4* yp = (const f32x4*)(Y + ((size_t)q * MS + rr) * DM + c); y0 = y0 + yp[0]; y1 = y1 + yp[1]; }
            const float* ga = modl + (size_t)b * NMOD + ga_off + c; const float* gs = gsn + (size_t)b * DM + c;
            const f32x4 g0 = *(const f32x4*)ga, g1 = *(const f32x4*)(ga + 4), s0 = *(const f32x4*)gs, s1 = *(const f32x4*)(gs + 4);
            f32x4 x0, x1;
            x0.x = __uint_as_float(xw.x << 16); x0.y = __uint_as_float(xw.x & 0xffff0000u); x0.z = __uint_as_float(xw.y << 16); x0.w = __uint_as_float(xw.y & 0xffff0000u);
            x1.x = __uint_as_float(xw.z << 16); x1.y = __uint_as_float(xw.z & 0xffff0000u); x1.z = __uint_as_float(xw.w << 16); x1.w = __uint_as_float(xw.w & 0xffff0000u);
            x0 = x0 + g0 * y0; x1 = x1 + g1 * y1;
            s += ((x0.x * x0.x + x0.y * x0.y) + (x0.z * x0.z + x0.w * x0.w)) + ((x1.x * x1.x + x1.y * x1.y) + (x1.z * x1.z + x1.w * x1.w));
            u32x4 w; w.x = pk2(x0.x, x0.y); w.y = pk2(x0.z, x0.w); w.z = pk2(x1.x, x1.y); w.w = pk2(x1.z, x1.w);
            *(u32x4*)(XB + (size_t)r * DM + c) = w;
            x0 = x0 * s0; x1 = x1 * s1;
            w.x = pk2(x0.x, x0.y); w.y = pk2(x0.z, x0.w); w.z = pk2(x1.x, x1.y); w.w = pk2(x1.z, x1.w);
            *(u32x4*)(XG + (size_t)r * DM + c) = w; }
        s = wave_sum(s);
        if (C.lane == 0) ss[r] = s;
    }
}

constexpr int AT_K = 0, AT_KROW = 144, AT_V = 192 * AT_KROW, AT_B = AT_V + 192 * 128, AT_END = AT_B + 4 * 256 * 4;
static_assert(AT_B % 16 == 0 && AT_END <= LDS_BYTES, "attention LDS map");
__device__ __forceinline__ unsigned off64(unsigned row, unsigned ch) { return 1024u * (row >> 3) + 512u * (ch >> 2) + 64u * (row & 7) + 16u * ((ch & 3) ^ ((row >> 2) & 3)); }
__device__ __forceinline__ void tr_read4(unsigned b0, unsigned b1, bf16x8 (&a)[2]) {
    s16x4 l0, l1, h0, h1;
    asm volatile("ds_read_b64_tr_b16 %0, %4\n\tds_read_b64_tr_b16 %1, %4 offset:512\n\tds_read_b64_tr_b16 %2, %5\n\tds_read_b64_tr_b16 %3, %5 offset:512\n\ts_waitcnt lgkmcnt(0)"
                 : "=&v"(l0), "=&v"(l1), "=&v"(h0), "=&v"(h1) : "v"(b0), "v"(b1) : "memory");
    a[0] = __builtin_shufflevector(l0, h0, 0, 1, 2, 3, 4, 5, 6, 7); a[1] = __builtin_shufflevector(l1, h1, 0, 1, 2, 3, 4, 5, 6, 7);
}
template <bool SAMPLE> __device__ __forceinline__ void att_unit(const Ctx& C, const bf16* U, bf16* MIX, const float* sinks, const float* btab  , const float* ck, const float* cv, int b, int c, int kvh) {
    LAS unsigned char* lds = C.lds;
    constexpr int NT = SAMPLE ? 5 : 6, NK = SAMPLE ? 144 : 192;
    const int rowq0 = SAMPLE ? MP + 16 * b : b * SEQ + 64 * c;
    if (C.tid < 256) *(LAS f32x4*)(lds + AT_B + 16 * C.tid) = *(const f32x4*)(btab + kvh * 1024 + 4 * C.tid);
    for (int ci = C.tid; ci < NT * 32 * 8; ci += 512) {
        const int jb = ci >> 3, ch = ci & 7;
        u32x4 kv = {0u, 0u, 0u, 0u}, vv = {0u, 0u, 0u, 0u};
        if (SAMPLE) {
            if (jb < 128) { const float* kp = ck + ((size_t)(b * 128 + jb) * 2 + kvh) * 64 + 8 * ch; const float* vp = cv + ((size_t)(b * 128 + jb) * 2 + kvh) * 64 + 8 * ch;
                const f32x4 k0 = *(const f32x4*)kp, k1 = *(const f32x4*)(kp + 4), v0 = *(const f32x4*)vp, v1 = *(const f32x4*)(vp + 4);
                kv.x = pk2(k0.x, k0.y); kv.y = pk2(k0.z, k0.w); kv.z = pk2(k1.x, k1.y); kv.w = pk2(k1.z, k1.w);
                vv.x = pk2(v0.x, v0.y); vv.y = pk2(v0.z, v0.w); vv.z = pk2(v1.x, v1.y); vv.w = pk2(v1.z, v1.w); }
            else if (jb < NK) { const bf16* rp = U + (size_t)(rowq0 + jb - 128) * INW + 512 + kvh * 64 + 8 * ch; kv = *(const u32x4*)rp; vv = *(const u32x4*)(rp + 128); }
        } else {
            const int s = 64 * (c - 2) + jb;
            if (s >= 0) { const bf16* rp = U + (size_t)(b * SEQ + s) * INW + 512 + kvh * 64 + 8 * ch; kv = *(const u32x4*)rp; vv = *(const u32x4*)(rp + 128); }
        }
        *(LAS u32x4*)(lds + AT_K + jb * AT_KROW + 16 * ch) = kv;
        *(LAS u32x4*)(lds + AT_V + off64(jb, ch)) = vv;
    }
    __syncthreads();
    const int w = C.wave, l31 = C.lane & 31, h = C.lane >> 5;
    if (!SAMPLE || w < 4) {
        const int g = SAMPLE ? w : (w >> 1), qi = SAMPLE ? l31 : 32 * (w & 1) + l31, head = kvh * 4 + g;
        const int qrow = rowq0 + (SAMPLE ? (qi < 16 ? qi : 15) : qi);
        const int t0 = SAMPLE ? 0 : (c == 0 ? 4 : (c == 1 ? 2 : 0));
        bf16x8 bq[4];
#pragma unroll
        for (int s = 0; s < 4; ++s) bq[s] = *(const bf16x8*)(U + (size_t)qrow * INW + head * 64 + 16 * s + 8 * h);
        f32x16 S[NT];
#pragma unroll
        for (int t = 0; t < NT; ++t) {
#pragma unroll
            for (int r = 0; r < 16; ++r) S[t][r] = 0.f;
            if (t >= t0) {
#pragma unroll
                for (int s = 0; s < 4; ++s) { const bf16x8 a = *(const LAS bf16x8*)(lds + AT_K + (32 * t + l31) * AT_KROW + (16 * s + 8 * h) * 2); S[t] = MFMA32(a, bq[s], S[t]); }
            }
        }
        const float sink2 = sinks[head] * LOG2E;
        const LAS float* bt = (const LAS float*)(lds + AT_B) + g * 256 + 63 - qi;
        float m = sink2;
#pragma unroll
        for (int t = 0; t < NT; ++t) if (t >= t0) {
#pragma unroll
            for (int r = 0; r < 16; ++r) { const int key = 32 * t + crow(r, h); float v = S[t][r] + bt[key]; if (SAMPLE && key >= NK) v = -1e30f; S[t][r] = v; m = fmaxf(m, v); }
        }
        m = fmaxf(m, __shfl_xor(m, 32));
        float lsum = 0.f;
#pragma unroll
        for (int t = 0; t < NT; ++t) if (t >= t0) {
#pragma unroll
            for (int r = 0; r < 16; ++r) { const float p = __builtin_amdgcn_exp2f(S[t][r] - m); S[t][r] = p; lsum += p; }
        }
        lsum += __shfl_xor(lsum, 32);
        lsum += __builtin_amdgcn_exp2f(sink2 - m);
        f32x16 O[2];
#pragma unroll
        for (int et = 0; et < 2; ++et)
#pragma unroll
            for (int r = 0; r < 16; ++r) O[et][r] = 0.f;
        const unsigned blk = (C.lane >> 4) & 1, q4 = (C.lane & 15) >> 2, p4 = C.lane & 3;
        const unsigned vb0 = (unsigned)(size_t)(lds + AT_V) + 64u * (4u * h + q4) + 16u * ((2u * blk + (p4 >> 1)) ^ (unsigned)h) + 8u * (p4 & 1);
        const unsigned vb1 = (unsigned)(size_t)(lds + AT_V) + 64u * (4u * h + q4) + 16u * ((2u * blk + (p4 >> 1)) ^ (2u + (unsigned)h)) + 8u * (p4 & 1) + 1024u;
#pragma unroll
        for (int t = 0; t < NT; ++t) if (t >= t0) {
#pragma unroll
            for (int sp = 0; sp < 2; ++sp) {
                u32x4 pw; pw.x = pk2(S[t][8 * sp + 0], S[t][8 * sp + 1]); pw.y = pk2(S[t][8 * sp + 2], S[t][8 * sp + 3]); pw.z = pk2(S[t][8 * sp + 4], S[t][8 * sp + 5]); pw.w = pk2(S[t][8 * sp + 6], S[t][8 * sp + 7]);
                const bf16x8 pb = __builtin_bit_cast(bf16x8, pw);
                bf16x8 av[2];
                tr_read4(vb0 + 1024u * (4 * t + 2 * sp), vb1 + 1024u * (4 * t + 2 * sp), av);
                __builtin_amdgcn_sched_barrier(0);
                O[0] = MFMA32(av[0], pb, O[0]); O[1] = MFMA32(av[1], pb, O[1]);
            }
        }
        const float inv = __builtin_amdgcn_rcpf(lsum);
        if (!SAMPLE || qi < 16) {
            bf16* op = MIX + (size_t)qrow * DM + head * 64;
#pragma unroll
            for (int et = 0; et < 2; ++et)
#pragma unroll
                for (int rg = 0; rg < 4; ++rg) { u32x2 wv; wv.x = pk2(O[et][4 * rg] * inv, O[et][4 * rg + 1] * inv); wv.y = pk2(O[et][4 * rg + 2] * inv, O[et][4 * rg + 3] * inv);
                    *(u32x2*)(op + 32 * et + 8 * rg + 4 * h) = wv; }
        }
    }
    __syncthreads();
}

constexpr int AS_K = 0, AS_V = 384 * AT_KROW, AS_B = AS_V + 384 * 128, AS_END = AS_B + 4 * 256 * 4;
static_assert(AS_V % 16 == 0 && AS_B % 16 == 0 && AS_END <= MISC_OFF, "attention (4-chunk) LDS map");
__device__ __forceinline__ void att_super(const Ctx& C, const bf16* U, bf16* MIX, const float* sinks, const float* btab  , int b, int kvh, int c0) {
    LAS unsigned char* lds = C.lds;
    if (C.tid < 256) *(LAS f32x4*)(lds + AS_B + 16 * C.tid) = *(const f32x4*)(btab + kvh * 1024 + 4 * C.tid);
    for (int ci = C.tid; ci < 384 * 8; ci += 512) {
        const int jl = ci >> 3, ch = ci & 7;
        u32x4 kv = {0u, 0u, 0u, 0u}, vv = {0u, 0u, 0u, 0u};
        const int s = 64 * (c0 - 2) + jl;
        if (s >= 0) { const bf16* rp = U + (size_t)(b * SEQ + s) * INW + 512 + kvh * 64 + 8 * ch; kv = *(const u32x4*)rp; vv = *(const u32x4*)(rp + 128); }
        *(LAS u32x4*)(lds + AS_K + jl * AT_KROW + 16 * ch) = kv;
        *(LAS u32x4*)(lds + AS_V + off64(jl, ch)) = vv;
    }
    const int w = C.wave, l31 = C.lane & 31, h = C.lane >> 5;
    const int g = w >> 1, qi = 32 * (w & 1) + l31, head = kvh * 4 + g;
    const float sink2 = sinks[head] * LOG2E;
    bf16x8 bq[4];
#pragma unroll
    for (int s = 0; s < 4; ++s) bq[s] = *(const bf16x8*)(U + (size_t)(b * SEQ + 64 * c0 + qi) * INW + head * 64 + 16 * s + 8 * h);
    __syncthreads();
    const LAS float* bt = (const LAS float*)(lds + AS_B) + g * 256 + 63 - qi;
    const unsigned blk = (C.lane >> 4) & 1, q4 = (C.lane & 15) >> 2, p4 = C.lane & 3;
    const unsigned vb0 = (unsigned)(size_t)(lds + AS_V) + 64u * (4u * h + q4) + 16u * ((2u * blk + (p4 >> 1)) ^ (unsigned)h) + 8u * (p4 & 1);
    const unsigned vb1 = (unsigned)(size_t)(lds + AS_V) + 64u * (4u * h + q4) + 16u * ((2u * blk + (p4 >> 1)) ^ (2u + (unsigned)h)) + 8u * (p4 & 1) + 1024u;
#pragma unroll 1
    for (int q = 0; q < 4; ++q) {
        const int c = c0 + q, qrow = b * SEQ + 64 * c + qi;
        const int t0 = c == 0 ? 4 : (c == 1 ? 2 : 0);
        bf16x8 bqn[4];
        { const int qn = q < 3 ? q + 1 : 3;
#pragma unroll
          for (int s = 0; s < 4; ++s) bqn[s] = *(const bf16x8*)(U + (size_t)(b * SEQ + 64 * (c0 + qn) + qi) * INW + head * 64 + 16 * s + 8 * h); }
        f32x16 S[6];
#pragma unroll
        for (int t = 0; t < 6; ++t) {
#pragma unroll
            for (int r = 0; r < 16; ++r) S[t][r] = 0.f;
            if (t >= t0) {
#pragma unroll
                for (int s = 0; s < 4; ++s) { const bf16x8 a = *(const LAS bf16x8*)(lds + AS_K + (64 * q + 32 * t + l31) * AT_KROW + (16 * s + 8 * h) * 2); S[t] = MFMA32(a, bq[s], S[t]); }
            }
        }
        float m = sink2;
#pragma unroll
        for (int t = 0; t < 6; ++t) if (t >= t0) {
#pragma unroll
            for (int r = 0; r < 16; ++r) { const float v = S[t][r] + bt[32 * t + crow(r, h)]; S[t][r] = v; m = fmaxf(m, v); }
        }
        m = fmaxf(m, __shfl_xor(m, 32));
        float lsum = 0.f;
#pragma unroll
        for (int t = 0; t < 6; ++t) if (t >= t0) {
#pragma unroll
            for (int r = 0; r < 16; ++r) { const float p = __builtin_amdgcn_exp2f(S[t][r] - m); S[t][r] = p; lsum += p; }
        }
        lsum += __shfl_xor(lsum, 32);
        lsum += __builtin_amdgcn_exp2f(sink2 - m);
        f32x16 O[2];
#pragma unroll
        for (int et = 0; et < 2; ++et)
#pragma unroll
            for (int r = 0; r < 16; ++r) O[et][r] = 0.f;
#pragma unroll
        for (int t = 0; t < 6; ++t) if (t >= t0) {
#pragma unroll
            for (int sp = 0; sp < 2; ++sp) {
                u32x4 pw; pw.x = pk2(S[t][8 * sp + 0], S[t][8 * sp + 1]); pw.y = pk2(S[t][8 * sp + 2], S[t][8 * sp + 3]); pw.z = pk2(S[t][8 * sp + 4], S[t][8 * sp + 5]); pw.w = pk2(S[t][8 * sp + 6], S[t][8 * sp + 7]);
                const bf16x8 pb = __builtin_bit_cast(bf16x8, pw);
                bf16x8 av[2];
                const unsigned ko = 1024u * (unsigned)(8 * q + 4 * t + 2 * sp);
                tr_read4(vb0 + ko, vb1 + ko, av);
                __builtin_amdgcn_sched_barrier(0);
                O[0] = MFMA32(av[0], pb, O[0]); O[1] = MFMA32(av[1], pb, O[1]);
            }
        }
        const float inv = __builtin_amdgcn_rcpf(lsum);
        bf16* op = MIX + (size_t)qrow * DM + head * 64;
#pragma unroll
        for (int et = 0; et < 2; ++et)
#pragma unroll
            for (int rp = 0; rp < 2; ++rp) {
                const unsigned ax = pk2(O[et][8 * rp] * inv, O[et][8 * rp + 1] * inv), ay = pk2(O[et][8 * rp + 2] * inv, O[et][8 * rp + 3] * inv);
                const unsigned bx = pk2(O[et][8 * rp + 4] * inv, O[et][8 * rp + 5] * inv), by = pk2(O[et][8 * rp + 6] * inv, O[et][8 * rp + 7] * inv);
                const auto r0 = __builtin_amdgcn_permlane32_swap(ax, bx, false, false), r1 = __builtin_amdgcn_permlane32_swap(ay, by, false, false);
                u32x4 wv; wv.x = r0[0]; wv.y = r1[0]; wv.z = r0[1]; wv.w = r1[1];
                *(u32x4*)(op + 32 * et + 16 * rp + 8 * h) = wv; }
#pragma unroll
        for (int s = 0; s < 4; ++s) bq[s] = bqn[s];
    }
    __syncthreads();
}

constexpr int RT_ROW = 528, RT_IMG = 128 * RT_ROW;
static_assert(2 * RT_IMG <= MISC_OFF && NBT * DM * 4 <= MISC_OFF, "retention / adaLN LDS maps stay below the control words");
template <bool SCALE> __device__ __forceinline__ void ret_fill_T(const Ctx& C, LAS unsigned char* img, const bf16* src  , int ntok, int npad, float l2g, int jlast) {
    for (int ci = C.tid; ci < npad * 16; ci += 512) {
        const int j = ci % npad, ch = ci / npad;
        u32x4 v = {0u, 0u, 0u, 0u};
        if (j < ntok) v = *(const u32x4*)(src + (size_t)j * INW + 8 * ch);
        unsigned short e[8] = {(unsigned short)(v.x & 0xffff), (unsigned short)(v.x >> 16), (unsigned short)(v.y & 0xffff), (unsigned short)(v.y >> 16), (unsigned short)(v.z & 0xffff), (unsigned short)(v.z >> 16), (unsigned short)(v.w & 0xffff), (unsigned short)(v.w >> 16)};
        if (SCALE) { const float f = __builtin_amdgcn_exp2f((float)(jlast - j) * l2g);
#pragma unroll
            for (int i = 0; i < 8; i += 2) { const unsigned p = pk2(bf2f(e[i]) * f, bf2f(e[i + 1]) * f); e[i] = (unsigned short)(p & 0xffff); e[i + 1] = (unsigned short)(p >> 16); } }
        LAS bf16* dst = (LAS bf16*)(img + (8 * ch) * RT_ROW) + j;
#pragma unroll
        for (int i = 0; i < 8; ++i) dst[i * (RT_ROW / 2)] = e[i];
    }
}
__device__ __forceinline__ void r1_unit(const Ctx& C, const bf16* U, float* DT, int b, int t, int hd) {
    LAS unsigned char* lds = C.lds;
    const float l2g = log2gamma(hd);
    const bf16* base = U + (size_t)(b * SEQ + 256 * t) * INW;
    ret_fill_T<true>(C, lds, base + 1280 + 128 * hd, 256, 256, l2g, 255);
    ret_fill_T<false>(C, lds + RT_IMG, base + 1792 + 128 * hd, 256, 256, 0.f, 0);
    __syncthreads();
    const int w = C.wave, l31 = C.lane & 31, h = C.lane >> 5, et = w >> 1, dh = w & 1;
    f32x16 acc[2];
#pragma unroll
    for (int i = 0; i < 2; ++i)
#pragma unroll
        for (int r = 0; r < 16; ++r) acc[i][r] = 0.f;
#pragma unroll 4
    for (int s = 0; s < 16; ++s) {
        const bf16x8 a = *(const LAS bf16x8*)(lds + RT_IMG + (32 * et + l31) * RT_ROW + (16 * s + 8 * h) * 2);
#pragma unroll
        for (int dt = 0; dt < 2; ++dt) { const bf16x8 bb = *(const LAS bf16x8*)(lds + (32 * (2 * dh + dt) + l31) * RT_ROW + (16 * s + 8 * h) * 2); acc[dt] = MFMA32(a, bb, acc[dt]); }
    }
    float* out = DT + ((size_t)((b * NTILE_B + t) * 4 + hd) << 14);
#pragma unroll
    for (int dt = 0; dt < 2; ++dt)
#pragma unroll
        for (int r = 0; r < 16; ++r) out[(32 * et + crow(r, h)) * 128 + 32 * (2 * dh + dt) + l31] = acc[dt][r];
    __syncthreads();
}
__device__ __forceinline__ void phase_scan(const Ctx& C, const bf16* DT, bf16* SST, float* rsp) {
    for (int idx = C.vcu * 512 + C.tid; idx < NBP * 4 * 16384; idx += C.G * 512) {
        const int bh = idx >> 14, ed = idx & 16383, b = bh >> 2, hd = bh & 3;
        const float cd = __builtin_amdgcn_exp2f(256.f * log2gamma(hd));
        float s = 0.f;
        const size_t o0 = ((size_t)(b * NTILE_B * 4 + hd) << 14) + ed;
        float d[NTILE_B];
#pragma unroll
        for (int t = 0; t < NTILE_B; ++t) d[t] = bf2f(DT[o0 + ((size_t)t << 16)]);
#pragma unroll
        for (int t = 0; t < NTILE_B; ++t) { SST[o0 + ((size_t)t << 16)] = (bf16)(pk2(s, 0.f) & 0xffff); s = cd * s + d[t]; }
        rsp[((size_t)bh << 14) + (ed & 127) * 128 + (ed >> 7)] = s;
    }
}
template <bool SAMPLE> __device__ __forceinline__ void r3_unit(const Ctx& C, const bf16* U, bf16* MIX, const bf16* sst  , int row0, int hd, const float* s0  , float* snew) {
    LAS unsigned char* lds = C.lds;
    const float l2g = log2gamma(hd);
    const bf16* base = U + (size_t)row0 * INW;
    ret_fill_T<false>(C, lds, base + 1792 + 128 * hd, SAMPLE ? 16 : 256, SAMPLE ? 32 : 256, 0.f, 0);
    __syncthreads();
    const int w = C.wave, l31 = C.lane & 31, h = C.lane >> 5;
    if (!SAMPLE || w == 0) {
        const int i = 32 * w + l31;
        const int qrow = row0 + (SAMPLE ? (i < 16 ? i : 15) : i);
        bf16x8 bq[8];
#pragma unroll
        for (int s = 0; s < 8; ++s) bq[s] = *(const bf16x8*)(U + (size_t)qrow * INW + 768 + 128 * hd + 16 * s + 8 * h);
        f32x16 O[4];
#pragma unroll
        for (int et = 0; et < 4; ++et)
#pragma unroll
            for (int r = 0; r < 16; ++r) O[et][r] = 0.f;
#pragma unroll
        for (int s = 0; s < 8; ++s)
#pragma unroll
            for (int et = 0; et < 4; ++et) { const bf16x8 a = *(const bf16x8*)(sst + (size_t)(32 * et + l31) * 128 + 16 * s + 8 * h); O[et] = MFMA32(a, bq[s], O[et]); }
        const float qd = __builtin_amdgcn_exp2f((float)(i + 1) * l2g);
#pragma unroll
        for (int et = 0; et < 4; ++et)
#pragma unroll
            for (int r = 0; r < 16; ++r) O[et][r] *= qd;
        for (int kt = 0; kt <= w; ++kt) {
            f32x16 ST;
#pragma unroll
            for (int r = 0; r < 16; ++r) ST[r] = 0.f;
            const int krow = row0 + (SAMPLE ? (l31 < 16 ? l31 : 15) : 32 * kt + l31);
#pragma unroll
            for (int s = 0; s < 8; ++s) { const bf16x8 a = *(const bf16x8*)(U + (size_t)krow * INW + 1280 + 128 * hd + 16 * s + 8 * h); ST = MFMA32(a, bq[s], ST); }
#pragma unroll
            for (int r = 0; r < 16; ++r) { const int df = i - (32 * kt + crow(r, h)); ST[r] = df >= 0 ? ST[r] * __builtin_amdgcn_exp2f((float)df * l2g) : 0.f; }
#pragma unroll
            for (int sp = 0; sp < 2; ++sp) {
                u32x4 pw; pw.x = pk2(ST[8 * sp + 0], ST[8 * sp + 1]); pw.y = pk2(ST[8 * sp + 2], ST[8 * sp + 3]); pw.z = pk2(ST[8 * sp + 4], ST[8 * sp + 5]); pw.w = pk2(ST[8 * sp + 6], ST[8 * sp + 7]);
                const bf16x8 pb = __builtin_bit_cast(bf16x8, pw);
#pragma unroll
                for (int et = 0; et < 4; ++et) {
                    const LAS unsigned char* vp = lds + (32 * et + l31) * RT_ROW + (32 * kt + 16 * sp + 4 * h) * 2;
                    const s16x4 lo = *(const LAS s16x4*)vp, hi = *(const LAS s16x4*)(vp + 16);
                    const bf16x8 a = __builtin_shufflevector(lo, hi, 0, 1, 2, 3, 4, 5, 6, 7);
                    O[et] = MFMA32(a, pb, O[et]);
                }
            }
        }
        float ss = 0.f;
#pragma unroll
        for (int et = 0; et < 4; ++et)
#pragma unroll
            for (int r = 0; r < 16; ++r) ss += O[et][r] * O[et][r];
        ss += __shfl_xor(ss, 32);
        const float rn = __builtin_amdgcn_rsqf(ss * (1.0f / 128.f) + EPS);
        if (!SAMPLE || i < 16) {
            const bf16* gp = U + (size_t)qrow * INW + 2304 + 128 * hd; bf16* op = MIX + (size_t)qrow * DM + 512 + 128 * hd;
#pragma unroll
            for (int et = 0; et < 4; ++et)
#pragma unroll
                for (int rg = 0; rg < 4; ++rg) { const int e = 32 * et + 8 * rg + 4 * h; const u32x2 gw = *(const u32x2*)(gp + e);
                    const float g0 = bf2f((unsigned short)(gw.x & 0xffff)), g1 = bf2f((unsigned short)(gw.x >> 16)), g2 = bf2f((unsigned short)(gw.y & 0xffff)), g3 = bf2f((unsigned short)(gw.y >> 16));
                    u32x2 wv; wv.x = pk2(O[et][4 * rg] * rn * g0, O[et][4 * rg + 1] * rn * g1); wv.y = pk2(O[et][4 * rg + 2] * rn * g2, O[et][4 * rg + 3] * rn * g3);
                    *(u32x2*)(op + e) = wv; }
        }
    }
    __syncthreads();
}
__device__ __forceinline__ void r3s_state(const Ctx& C, const bf16* U, int row0, int hd, const float* s0, float* snew) {
    LAS unsigned char* lds = C.lds;
    const float l2g = log2gamma(hd);
    const bf16* base = U + (size_t)row0 * INW;
    LAS float* kk = (LAS float*)lds; LAS float* vv = kk + 16 * 128;
    for (int q = C.tid; q < 16 * 128; q += 512) { const int j = q >> 7, f = q & 127;
        kk[q] = bf2f(base[(size_t)j * INW + 1280 + 128 * hd + f]) * __builtin_amdgcn_exp2f((float)(15 - j) * l2g); vv[q] = bf2f(base[(size_t)j * INW + 1792 + 128 * hd + f]); }
    __syncthreads();
    const float g16 = __builtin_amdgcn_exp2f(16.f * l2g); const int e = C.tid & 127;
    for (int d = C.tid >> 7; d < 128; d += 4) { float a = g16 * s0[d * 128 + e];
#pragma unroll
        for (int j = 0; j < 16; ++j) a += kk[j * 128 + d] * vv[j * 128 + e];
        snew[d * 128 + e] = a; }
    __syncthreads();
}

__device__ __forceinline__ unsigned off_a(unsigned row, unsigned ch) { return 2048u * (row >> 3) + 512u * (ch >> 2) + 64u * (row & 7) + 16u * ((ch & 3) ^ ((row >> 2) & 3)); }
__device__ __forceinline__ void tr_read8(unsigned b0, unsigned b1, bf16x8 (&a)[4]) {
    s16x4 l0, l1, l2, l3, h0, h1, h2, h3;
    asm volatile("ds_read_b64_tr_b16 %0, %8\n\tds_read_b64_tr_b16 %1, %8 offset:512\n\tds_read_b64_tr_b16 %2, %8 offset:1024\n\tds_read_b64_tr_b16 %3, %8 offset:1536\n\t"
                 "ds_read_b64_tr_b16 %4, %9\n\tds_read_b64_tr_b16 %5, %9 offset:512\n\tds_read_b64_tr_b16 %6, %9 offset:1024\n\tds_read_b64_tr_b16 %7, %9 offset:1536\n\ts_waitcnt lgkmcnt(0)"
                 : "=&v"(l0), "=&v"(l1), "=&v"(l2), "=&v"(l3), "=&v"(h0), "=&v"(h1), "=&v"(h2), "=&v"(h3) : "v"(b0), "v"(b1) : "memory");
    a[0] = __builtin_shufflevector(l0, h0, 0, 1, 2, 3, 4, 5, 6, 7); a[1] = __builtin_shufflevector(l1, h1, 0, 1, 2, 3, 4, 5, 6, 7);
    a[2] = __builtin_shufflevector(l2, h2, 0, 1, 2, 3, 4, 5, 6, 7); a[3] = __builtin_shufflevector(l3, h3, 0, 1, 2, 3, 4, 5, 6, 7);
}
__device__ __forceinline__ void r3_pair(const Ctx& C, const bf16* U, bf16* MIX, const bf16* sst2  , int row0, int hp) {
    LAS unsigned char* lds = C.lds;
    const bf16* base = U + (size_t)row0 * INW;
    for (int ci = C.tid; ci < 2 * 4096; ci += 512) {
        const int hh = ci >> 12, row = (ci >> 4) & 255, ch = ci & 15;
        const u32x4 v = *(const u32x4*)(base + (size_t)row * INW + 1792 + 128 * (2 * hp + hh) + 8 * ch);
        *(LAS u32x4*)(lds + 65536 * hh + off_a(row, ch)) = v;
    }
    __syncthreads();
    const int w = C.wave, l31 = C.lane & 31, h = C.lane >> 5;
    const unsigned blk = (C.lane >> 4) & 1, q = (C.lane & 15) >> 2, p = C.lane & 3;
    const unsigned tb0 = 64u * (4u * h + q) + 16u * ((2u * blk + (p >> 1)) ^ (unsigned)h) + 8u * (p & 1);
    const unsigned tb1 = 64u * (4u * h + q) + 16u * ((2u * blk + (p >> 1)) ^ (2u + (unsigned)h)) + 8u * (p & 1) + 2048u;
    for (int pass = 0; pass < 2; ++pass) {
        const int hd = 2 * hp + pass, qt = pass ? 7 - w : w;
        const float l2g = log2gamma(hd);
        const unsigned img = (unsigned)(size_t)(lds + 65536 * pass);
        const int i = 32 * qt + l31, qrow = row0 + i;
        const bf16* sst = sst2 + (size_t)pass * 16384;
        bf16x8 bq[8];
#pragma unroll
        for (int s = 0; s < 8; ++s) bq[s] = *(const bf16x8*)(U + (size_t)qrow * INW + 768 + 128 * hd + 16 * s + 8 * h);
        f32x16 O[4];
#pragma unroll
        for (int et = 0; et < 4; ++et)
#pragma unroll
            for (int r = 0; r < 16; ++r) O[et][r] = 0.f;
#pragma unroll
        for (int s = 0; s < 8; ++s)
#pragma unroll
            for (int et = 0; et < 4; ++et) { const bf16x8 a = *(const bf16x8*)(sst + (size_t)(32 * et + l31) * 128 + 16 * s + 8 * h); O[et] = MFMA32(a, bq[s], O[et]); }
        const float qd = __builtin_amdgcn_exp2f((float)(i + 1) * l2g);
#pragma unroll
        for (int et = 0; et < 4; ++et)
#pragma unroll
            for (int r = 0; r < 16; ++r) O[et][r] *= qd;
        for (int kt = 0; kt <= qt; ++kt) {
            f32x16 ST;
#pragma unroll
            for (int r = 0; r < 16; ++r) ST[r] = 0.f;
            const bf16* kp = base + (size_t)(32 * kt + l31) * INW + 1280 + 128 * hd + 8 * h;
#pragma unroll
            for (int s = 0; s < 8; ++s) { const bf16x8 a = *(const bf16x8*)(kp + 16 * s); ST = MFMA32(a, bq[s], ST); }
#pragma unroll
            for (int r = 0; r < 16; ++r) { const int df = i - (32 * kt + crow(r, h)); ST[r] = df >= 0 ? ST[r] * __builtin_amdgcn_exp2f((float)df * l2g) : 0.f; }
#pragma unroll
            for (int sp = 0; sp < 2; ++sp) {
                u32x4 pw; pw.x = pk2(ST[8 * sp + 0], ST[8 * sp + 1]); pw.y = pk2(ST[8 * sp + 2], ST[8 * sp + 3]); pw.z = pk2(ST[8 * sp + 4], ST[8 * sp + 5]); pw.w = pk2(ST[8 * sp + 6], ST[8 * sp + 7]);
                const bf16x8 pb = __builtin_bit_cast(bf16x8, pw);
                bf16x8 av[4];
                const unsigned ko = img + 2048u * (unsigned)(4 * kt + 2 * sp);
                tr_read8(ko + tb0, ko + tb1, av);
                __builtin_amdgcn_sched_barrier(0);
#pragma unroll
                for (int et = 0; et < 4; ++et) O[et] = MFMA32(av[et], pb, O[et]);
            }
        }
        float ss = 0.f;
#pragma unroll
        for (int et = 0; et < 4; ++et)
#pragma unroll
            for (int r = 0; r < 16; ++r) ss += O[et][r] * O[et][r];
        ss += __shfl_xor(ss, 32);
        const float rn = __builtin_amdgcn_rsqf(ss * (1.0f / 128.f) + EPS);
        const bf16* gp = U + (size_t)qrow * INW + 2304 + 128 * hd; bf16* op = MIX + (size_t)qrow * DM + 512 + 128 * hd;
#pragma unroll
        for (int et = 0; et < 4; ++et)
#pragma unroll
            for (int rg = 0; rg < 4; ++rg) { const int e = 32 * et + 8 * rg + 4 * h; const u32x2 gw = *(const u32x2*)(gp + e);
                const float g0 = bf2f((unsigned short)(gw.x & 0xffff)), g1 = bf2f((unsigned short)(gw.x >> 16)), g2 = bf2f((unsigned short)(gw.y & 0xffff)), g3 = bf2f((unsigned short)(gw.y >> 16));
                u32x2 wv; wv.x = pk2(O[et][4 * rg] * rn * g0, O[et][4 * rg + 1] * rn * g1); wv.y = pk2(O[et][4 * rg + 2] * rn * g2, O[et][4 * rg + 3] * rn * g3);
                *(u32x2*)(op + e) = wv; }
    }
    __syncthreads();
}

__device__ __forceinline__ bf16x8 tr_read2(unsigned a0, unsigned a1) {
    s16x4 lo, hi;
    asm volatile("ds_read_b64_tr_b16 %0, %2\n\tds_read_b64_tr_b16 %1, %3\n\ts_waitcnt lgkmcnt(0)" : "=&v"(lo), "=&v"(hi) : "v"(a0), "v"(a1) : "memory");
    return __builtin_shufflevector(lo, hi, 0, 1, 2, 3, 4, 5, 6, 7);
}
__device__ __forceinline__ void r3_one(const Ctx& C, const bf16* U, bf16* MIX, const bf16* sst  , int row0, int hd, int pf) {
    LAS unsigned char* lds = C.lds;
    const bf16* base = U + (size_t)row0 * INW;
    const int w = C.wave, l31 = C.lane & 31, h = C.lane >> 5;
    const int i = 32 * w + l31, qrow = row0 + i;
    for (int ci = C.tid; ci < 4096 + 2048; ci += 512) {
        if (ci < 4096) { const int row = ci >> 4, ch = ci & 15; *(LAS u32x4*)(lds + off_a(row, ch)) = *(const u32x4*)(base + (size_t)row * INW + 1792 + 128 * hd + 8 * ch); }
        else { const int cj = ci - 4096, row = cj >> 4, ch = cj & 15; *(LAS u32x4*)(lds + 65536 + off_a(row, ch)) = *(const u32x4*)(sst + (size_t)row * 128 + 8 * ch); }
    }
    __syncthreads();
    const unsigned blk = (C.lane >> 4) & 1, q = (C.lane & 15) >> 2, p = C.lane & 3;
    const unsigned tb0 = 64u * (4u * h + q) + 16u * ((2u * blk + (p >> 1)) ^ (unsigned)h) + 8u * (p & 1);
    const unsigned tb1 = 64u * (4u * h + q) + 16u * ((2u * blk + (p >> 1)) ^ (2u + (unsigned)h)) + 8u * (p & 1) + 2048u;
    const float l2g = log2gamma(hd);
    const unsigned img = (unsigned)(size_t)lds;
    f32x16 O[4];
#pragma unroll
    for (int et = 0; et < 4; ++et)
#pragma unroll
        for (int r = 0; r < 16; ++r) O[et][r] = 0.f;
    bf16x8 bq[8];
#pragma unroll
    for (int s = 0; s < 8; ++s) bq[s] = *(const bf16x8*)(U + (size_t)qrow * INW + 768 + 128 * hd + 16 * s + 8 * h);
    if (!(pf & 32)) {
#pragma unroll
    for (int s = 0; s < 8; ++s)
#pragma unroll
        for (int et = 0; et < 4; ++et) { const bf16x8 a = *(const LAS bf16x8*)(lds + 65536 + off_a(32 * et + l31, 2 * s + h)); O[et] = MFMA32(a, bq[s], O[et]); }
    }
    __syncthreads();
    for (int ci = C.tid; ci < 4096; ci += 512) { const int row = ci >> 4, ch = ci & 15; *(LAS u32x4*)(lds + 65536 + off_a(row, ch)) = *(const u32x4*)(base + (size_t)row * INW + 1280 + 128 * hd + 8 * ch); }
    __syncthreads();
    const float qd = __builtin_amdgcn_exp2f((float)(i + 1) * l2g);
#pragma unroll
    for (int et = 0; et < 4; ++et)
#pragma unroll
        for (int r = 0; r < 16; ++r) O[et][r] *= qd;
    const float ai = __builtin_amdgcn_exp2f((float)i * l2g), g32 = __builtin_amdgcn_exp2f(-32.f * l2g);
    float cr[16];
#pragma unroll
    for (int r = 0; r < 16; ++r) cr[r] = __builtin_amdgcn_exp2f(-(float)crow(r, h) * l2g);
    float ag = ai;
    for (int kt = 0; kt <= ((pf & 64) ? -1 : w); ++kt) {
        f32x16 ST;
#pragma unroll
        for (int r = 0; r < 16; ++r) ST[r] = 0.f;
#pragma unroll
        for (int s = 0; s < 8; ++s) { const bf16x8 a = *(const LAS bf16x8*)(lds + 65536 + off_a(32 * kt + l31, 2 * s + h)); ST = MFMA32(a, bq[s], ST); }
        if (kt == w) {
#pragma unroll
            for (int r = 0; r < 16; ++r) ST[r] = (l31 - crow(r, h)) >= 0 ? ST[r] * (ag * cr[r]) : 0.f;
        } else {
#pragma unroll
            for (int r = 0; r < 16; ++r) ST[r] *= ag * cr[r];
        }
        ag *= g32;
#pragma unroll
        for (int sp = 0; sp < 2; ++sp) {
            u32x4 pw; pw.x = pk2(ST[8 * sp + 0], ST[8 * sp + 1]); pw.y = pk2(ST[8 * sp + 2], ST[8 * sp + 3]); pw.z = pk2(ST[8 * sp + 4], ST[8 * sp + 5]); pw.w = pk2(ST[8 * sp + 6], ST[8 * sp + 7]);
            const bf16x8 pb = __builtin_bit_cast(bf16x8, pw);
            bf16x8 av[4];
            const unsigned ko = img + 2048u * (unsigned)(4 * kt + 2 * sp);
            tr_read8(ko + tb0, ko + tb1, av);
            __builtin_amdgcn_sched_barrier(0);
#pragma unroll
            for (int et = 0; et < 4; ++et) O[et] = MFMA32(av[et], pb, O[et]);
        }
    }
    float ss = 0.f;
#pragma unroll
    for (int et = 0; et < 4; ++et)
#pragma unroll
        for (int r = 0; r < 16; ++r) ss += O[et][r] * O[et][r];
    ss += __shfl_xor(ss, 32);
    const float rn = __builtin_amdgcn_rsqf(ss * (1.0f / 128.f) + EPS);
    const bf16* gp = U + (size_t)qrow * INW + 2304 + 128 * hd; bf16* op = MIX + (size_t)qrow * DM + 512 + 128 * hd;
    if (pf & 128) { if (ss == 123.456f) op[0] = 0; } else
#pragma unroll
    for (int et = 0; et < 4; ++et)
#pragma unroll
        for (int rp = 0; rp < 2; ++rp) {
            float x[8];
#pragma unroll
            for (int j = 0; j < 4; ++j) { const auto r = __builtin_amdgcn_permlane32_swap(__float_as_uint(O[et][8 * rp + j] * rn), __float_as_uint(O[et][8 * rp + 4 + j] * rn), false, false);
                x[j] = __uint_as_float(r[0]); x[4 + j] = __uint_as_float(r[1]); }
            const int e = 32 * et + 16 * rp + 8 * h; const u32x4 gw = *(const u32x4*)(gp + e);
            u32x4 wv;
            wv.x = pk2(x[0] * __uint_as_float(gw.x << 16), x[1] * __uint_as_float(gw.x & 0xffff0000u)); wv.y = pk2(x[2] * __uint_as_float(gw.y << 16), x[3] * __uint_as_float(gw.y & 0xffff0000u));
            wv.z = pk2(x[4] * __uint_as_float(gw.z << 16), x[5] * __uint_as_float(gw.z & 0xffff0000u)); wv.w = pk2(x[6] * __uint_as_float(gw.w << 16), x[7] * __uint_as_float(gw.w & 0xffff0000u));
            *(u32x4*)(op + e) = wv; }
    __syncthreads();
}
__device__ __forceinline__ void r1_tr(const Ctx& C, const bf16* U, bf16* DT, int b, int t, int hd) {
    LAS unsigned char* lds = C.lds;
    const float l2g = log2gamma(hd);
    const bf16* base = U + (size_t)(b * SEQ + 256 * t) * INW;
    for (int ci = C.tid; ci < 2 * 4096; ci += 512) {
        const int im = ci >> 12, row = (ci >> 4) & 255, ch = ci & 15;
        u32x4 v = *(const u32x4*)(base + (size_t)row * INW + (im ? 1280 : 1792) + 128 * hd + 8 * ch);
        if (im) { const float f = __builtin_amdgcn_exp2f((float)(255 - row) * l2g);
            v.x = pk2(__uint_as_float(v.x << 16) * f, __uint_as_float(v.x & 0xffff0000u) * f); v.y = pk2(__uint_as_float(v.y << 16) * f, __uint_as_float(v.y & 0xffff0000u) * f);
            v.z = pk2(__uint_as_float(v.z << 16) * f, __uint_as_float(v.z & 0xffff0000u) * f); v.w = pk2(__uint_as_float(v.w << 16) * f, __uint_as_float(v.w & 0xffff0000u) * f); }
        *(LAS u32x4*)(lds + 65536 * im + off_a(row, ch)) = v;
    }
    __syncthreads();
    const int w = C.wave, l31 = C.lane & 31, h = C.lane >> 5, et = w >> 1, dh = w & 1;
    const unsigned blk = (C.lane >> 4) & 1, q = (C.lane & 15) >> 2, p = C.lane & 3;
    const unsigned tb0 = 64u * (4u * h + q) + 16u * ((2u * blk + (p >> 1)) ^ (unsigned)h) + 8u * (p & 1);
    const unsigned tb1 = 64u * (4u * h + q) + 16u * ((2u * blk + (p >> 1)) ^ (2u + (unsigned)h)) + 8u * (p & 1) + 2048u;
    const unsigned img = (unsigned)(size_t)lds;
    f32x16 acc[2];
#pragma unroll
    for (int i = 0; i < 2; ++i)
#pragma unroll
        for (int r = 0; r < 16; ++r) acc[i][r] = 0.f;
    const unsigned ta0 = img + tb0 + 512u * et, ta1 = img + tb1 + 512u * et, tk0 = img + 65536u + tb0 + 512u * (2 * dh), tk1 = img + 65536u + tb1 + 512u * (2 * dh);
    for (int s = 0; s < 16; ++s) {
        const unsigned ko = 4096u * (unsigned)s;
        s16x4 a0, a1, c0, c1, d0, d1;
        asm volatile("ds_read_b64_tr_b16 %0, %6\n\tds_read_b64_tr_b16 %1, %7\n\tds_read_b64_tr_b16 %2, %8\n\tds_read_b64_tr_b16 %3, %9\n\tds_read_b64_tr_b16 %4, %8 offset:512\n\tds_read_b64_tr_b16 %5, %9 offset:512\n\ts_waitcnt lgkmcnt(0)"
                     : "=&v"(a0), "=&v"(a1), "=&v"(c0), "=&v"(c1), "=&v"(d0), "=&v"(d1) : "v"(ta0 + ko), "v"(ta1 + ko), "v"(tk0 + ko), "v"(tk1 + ko) : "memory");
        const bf16x8 a = __builtin_shufflevector(a0, a1, 0, 1, 2, 3, 4, 5, 6, 7), b0 = __builtin_shufflevector(c0, c1, 0, 1, 2, 3, 4, 5, 6, 7), b1 = __builtin_shufflevector(d0, d1, 0, 1, 2, 3, 4, 5, 6, 7);
        __builtin_amdgcn_sched_barrier(0);
        acc[0] = MFMA32(a, b0, acc[0]); acc[1] = MFMA32(a, b1, acc[1]);
    }
    bf16* out = DT + ((size_t)((b * NTILE_B + t) * 4 + hd) << 14);
#pragma unroll
    for (int dt = 0; dt < 2; ++dt)
#pragma unroll
        for (int r = 0; r < 16; ++r) out[(32 * et + crow(r, h)) * 128 + 32 * (2 * dh + dt) + l31] = (bf16)(pk2(acc[dt][r], 0.f) & 0xffffu);
    __syncthreads();
}


#define XB_TMO      128
#define XB_XCNT(j)  (256  + 64 * (j))
#define XB_XSUB(j)  (1280 + 64 * (j))
#define XB_XGEN(j)  (2304 + 64 * (j))
#define XB_TOP      3328
#define XB_TOPGEN   3392
#define XCD_BAR_WORDS 3456
#define XB_SPIN_CAP (1u << 18)

__device__ __forceinline__ unsigned xb_ld(unsigned* p)              { return __hip_atomic_load(p, __ATOMIC_RELAXED, __HIP_MEMORY_SCOPE_AGENT); }
__device__ __forceinline__ unsigned xb_add(unsigned* p, unsigned v) { return __hip_atomic_fetch_add(p, v, __ATOMIC_RELAXED, __HIP_MEMORY_SCOPE_AGENT); }
__device__ __forceinline__ unsigned xb_xcc_id() { return (unsigned)__builtin_amdgcn_s_getreg((3 << 11) | 20) & 0xFu; }
#define XB_SPIN(cond, bar) do { unsigned _sp = 0; while (cond) { __builtin_amdgcn_s_sleep(1); \
    if ((++_sp & 255u) == 0u) { if (xb_ld(&(bar)[XB_TMO])) break; if (_sp > XB_SPIN_CAP) { atomicAdd(&(bar)[XB_TMO], 1u); break; } } } } while (0)

struct XcdBarrier {
    unsigned* bar; unsigned x;
    volatile LAS unsigned* st;
};

__device__ __forceinline__ XcdBarrier xcd_barrier_post(unsigned* bar, volatile LAS unsigned* st) {
    XcdBarrier b; b.bar = bar; b.x = xb_xcc_id(); b.st = st;
    if (threadIdx.x == 0) (void)xb_add(&bar[XB_XCNT(b.x)], 1u);
    return b;
}
__device__ __forceinline__ void xcd_barrier_complete(unsigned* bar, unsigned x, unsigned& nloc, unsigned& nx) {
    const unsigned G = gridDim.x * gridDim.y * gridDim.z;
    unsigned sum, cnt, mine, sp = 0u;
    for (;;) {
        sum = 0u; cnt = 0u; mine = 0u;
#pragma unroll
        for (unsigned j = 0; j < 16; ++j) { const unsigned c = xb_ld(&bar[XB_XCNT(j)]); sum += c; cnt += (c > 0u) ? 1u : 0u; mine = (j == x) ? c : mine; }
        if (sum == G) break;
        __builtin_amdgcn_s_sleep(1);
        if ((++sp & 255u) == 0u) { if (xb_ld(&bar[XB_TMO])) break; if (sp > XB_SPIN_CAP) { atomicAdd(&bar[XB_TMO], 1u); break; } }
    }
    nloc = mine > 0u ? mine : 1u; nx = cnt > 0u ? cnt : 1u;
}

__device__ __forceinline__ void xcd_barrier(const XcdBarrier& b, const int tid) {
    asm volatile("s_waitcnt vmcnt(0)" ::: "memory");
    __syncthreads();
    if (tid == 0) {
        unsigned* bar = b.bar;
        __builtin_amdgcn_s_waitcnt(0);
        unsigned nloc = b.st[0], nx = b.st[1];
        if (nloc == 0u) { xcd_barrier_complete(bar, b.x, nloc, nx); b.st[0] = nloc; b.st[1] = nx; }
        const unsigned old = xb_add(&bar[XB_XSUB(b.x)], 1u);
        const unsigned gen = old / nloc;
        if (old + 1u == (gen + 1u) * nloc) {
            __builtin_amdgcn_fence(__ATOMIC_RELEASE, "agent");
            asm volatile("s_waitcnt vmcnt(0)" ::: "memory");
            const unsigned og = xb_add(&bar[XB_TOP], 1u);
            const unsigned tg = og / nx;
            if (og + 1u == (tg + 1u) * nx) xb_add(&bar[XB_TOPGEN], 1u);
            else XB_SPIN(xb_ld(&bar[XB_TOPGEN]) == tg, bar);
            __builtin_amdgcn_fence(__ATOMIC_ACQUIRE, "agent");
            xb_add(&bar[XB_XGEN(b.x)], 1u);
            asm volatile("s_waitcnt vmcnt(0)" ::: "memory");
        } else {
            XB_SPIN(xb_ld(&bar[XB_XGEN(b.x)]) == gen, bar);
            __builtin_amdgcn_fence(__ATOMIC_ACQUIRE, "agent");
            asm volatile("s_waitcnt vmcnt(0)" ::: "memory");
        }
    }
    __syncthreads();
}

constexpr int NPHASE = 3 + 7 * NLAYER;
#ifndef PHMASK
#define PHMASK 0xFFFF
#endif
#define PHON(i) ((PHMASK >> (i)) & 1)
#ifndef MK_LAUNCHES
#define MK_LAUNCHES 1
#endif
__global__ void __launch_bounds__(512, 2) fwd_kernel(Params P) {
    extern __shared__ __attribute__((aligned(16))) unsigned char lds_raw[];
#if MK_LAUNCHES
    if (threadIdx.x < 64) ((LAS unsigned*)((LAS unsigned char*)lds_raw + MISC_OFF))[threadIdx.x] = 0u;
    __syncthreads();
    const XcdBarrier bar = xcd_barrier_post((unsigned*)(P.ws + WS_CTL), (volatile LAS unsigned*)((LAS unsigned char*)lds_raw + MISC_OFF));
#endif
    const int wave0 = __builtin_amdgcn_readfirstlane((int)threadIdx.x >> 6);
    for (int ph = P.ph_lo; ph < P.ph_hi; ++ph) {
        unsigned char* ws = P.ws; asm volatile("" : "+s"(ws));
        float* out = P.out; asm volatile("" : "+s"(out));
#define MKCTX() Ctx C; { unsigned z_ = 0u; asm volatile("" : "+v"(z_)); int tid_ = wave0 * 64 + (int)__builtin_amdgcn_mbcnt_hi(~0u, __builtin_amdgcn_mbcnt_lo(~0u, z_)); C.lds = (LAS unsigned char*)lds_raw; C.tid = tid_; C.lane = C.tid & 63; C.wave = __builtin_amdgcn_readfirstlane(C.tid >> 6); \
        int G_ = gridDim.x, bx_ = blockIdx.x; asm volatile("" : "+s"(G_), "+s"(bx_)); C.G = G_; C.vcu = (G_ % 8 == 0) ? (bx_ % 8) * (G_ / 8) + bx_ / 8 : bx_; }
        bf16* const XG = (bf16*)(ws + WS_XG); bf16* const U = (bf16*)(ws + WS_U); bf16* const MIX = (bf16*)(ws + WS_MIX); bf16* const HID = (bf16*)(ws + WS_HID);
        bf16* const DT = (bf16*)(ws + WS_DT); bf16* const SST = (bf16*)(ws + WS_SST);
        const float* const cs = (const float*)(ws + WS_CS);
        bf16* const XB = (bf16*)(ws + WS_XB) - (size_t)MP * DM; float* const SSA = (float*)(ws + WS_SSP); float* const SSB = SSA + MT;
        if (ph == 0) { if (PHON(0)) { MKCTX(); phase_prologue(C, P); } }
        else if (ph == 1 && !PHON(1)) { }
        else if (ph == NPHASE - 1) { if (PHON(8)) { MKCTX(); phase_final(C, XG, SSB, out + O_Y); } }
        else {
            const int l = ph == 1 ? 0 : (ph - 2) / 7, k = ph == 1 ? 7 : (ph - 2) % 7;
            const float* modl = (const float*)(ws + WS_MOD) + (size_t)l * NBT * NMOD;
            if (k == 0 || k == 2 || k == 4 || k == 5 || k == 6 || k == 7) { if (PHON(2)) { MKCTX();
                if (k == 7) phase_prologue2(C, P);
                if (k == 2) { phase_scan(C, DT, SST, out + O_RSP + (size_t)l * 131072);
                    for (int u = ((int)blockIdx.x + C.G - 64 % C.G) % C.G; u < DBS * 4; u += C.G) { const int hd = u & 3, j = u >> 2; const size_t so = ((size_t)(l * DBS + j) * 4 + hd) << 14;
                        r3s_state(C, U, MP + 16 * j, hd, P.in[I_SR] + so, out + O_RSS + so); } }
                if (k == 6) phase_fz<KS4>(C, XB, XG, (const float*)(ws + WS_Y4), SSB, modl, 5 * DM, (const float*)(ws + WS_GS) + (size_t)(2 * l + 2) * NBT * DM);
                const int ncall = (k == 4 || k == 5 || (k == 0 && l == 0)) ? 2 : 1;
                for (int sc = 0; sc < ncall; ++sc) {
                    int sub = 0, cidx = (int)blockIdx.x, Gc = C.G;
                    const bool cv = k == 7 || (k == 0 && sc == 1);
                    if (cv) { constexpr int n1 = INW / 256, n2 = DFF / 256; const int bx = (int)blockIdx.x; Gc = 1 << 20; cidx = 1 << 20;
                        if (k == 7) { if (bx < n1) { sub = 0; cidx = bx; } }
                        else { const int i = bx - (C.G - (n1 + 2 * n2)); if (i >= 0 && i < n2) { sub = 1; cidx = i; } else if (i >= n2 && i < n2 + n1) { sub = 2; cidx = i - n2; } else if (i >= n2 + n1 && i < n1 + 2 * n2) { sub = 3; cidx = i - n2 - n1; } } }
                    const int sl = cv ? (sub >> 1) : l; const bool cup = (sub & 1) != 0;
                    const int st = cv ? (cup ? 1 : 0) : k == 0 ? 0 : k == 2 ? 2 : k == 4 ? (sc ? 1 : 2) : k == 5 ? (sc ? 3 : 1) : 3;
                    const bool samp = k == 2 || ((k == 4 || k == 5) && sc == 1);
                    const int N = st == 0 ? INW : (st == 1 ? DFF : DM), ld = st == 3 ? LDH : DM, Kfull = st == 3 ? DFF : DM;
                    const int ks = (samp && st == 2) ? KS2 : ((samp && st == 3) ? KS4 : 1), K = Kfull / ks;
                    const int M = cv ? 256 : (samp ? MS : (k == 0 ? MT : MP)), pm0 = samp ? MP / 256 : 0;
                    const bf16* A = cv ? (const bf16*)(ws + WS_SHM) + (size_t)sub * 256 * DM : (st == 0 || st == 1) ? XG : (st == 2 ? MIX : HID);
                    const bf16* Bt = st == 0 ? (const bf16*)(ws + WS_WIN) + (size_t)sl * INW * DM : st == 1 ? (const bf16*)(ws + WS_WUP) + (size_t)sl * DFF * DM : st == 2 ? (const bf16*)(ws + WS_WOUT) + (size_t)sl * DM * DM : (const bf16*)(ws + WS_WDN) + (size_t)sl * DM * LDH;
                    pg8::Gemm g{A, Bt, M, N, K, ld, DM * 2, ((st == 2 || st == 3) && !samp && !cv) ? (const char*)XG : nullptr}; pg8::StaticOrder S; S.init(M, N, Gc, cidx, pm0, ks, K * 2);
                    EpiAll E; E.kind = cv ? 4 : (samp && st == 2) ? 5 : (samp && st == 3) ? 6 : st == 0 ? 0 : st == 1 ? 1 : st == 2 ? 2 : 3; E.l = cv ? sub : l; E.ws = ws; E.out = out;
                    int tq = C.tid; asm volatile("" : "+v"(tq));
                    pg8::gemm_phase<EpiAll, pg8::StaticOrder, true, true>(C.lds, g, S, E, tq);
                } }
            } else if (k == 1) {
                if (PHON(5)) { MKCTX(); const Ctx C0 = C;
                    if (P.pad & 1) for (int su = C0.vcu; su < 256; su += C0.G) { Ctx C = C0; asm volatile("" : "+v"(C.tid)); C.lane = C.tid & 63;
                        att_super(C, U, MIX, P.in[I_SINK] + l * 8, (const float*)(ws + WS_BT), su >> 7, (su >> 6) & 1, 4 * (su & 63)); }
                    for (int u = C0.vcu; u < 704; u += C0.G) {
                    Ctx C = C0; asm volatile("" : "+v"(C.tid)); C.lane = C.tid & 63;
                    if (u < 512) { if (!(P.pad & 2)) continue; const int hd = u & 3, t = (u >> 2) & 63, b = u >> 8; r1_tr(C, U, DT, b, t, hd); }
                    else if (u < 576) { if (!(P.pad & 4)) continue; const int v = u - 512, kvh = v & 1, j = v >> 1; att_unit<true>(C, U, MIX, P.in[I_SINK] + l * 8, (const float*)(ws + WS_BT), P.in[I_CK] + (size_t)l * DBS * 16384, P.in[I_CV] + (size_t)l * DBS * 16384, j, 0, kvh); }
                    else { if (!(P.pad & 4)) continue; const int v = u - 576, hd = v & 3, j = v >> 2; const size_t so = ((size_t)(l * DBS + j) * 4 + hd) << 14;
                        r3_unit<true>(C, U, MIX, (const bf16*)(ws + WS_SS0) + so, MP + 16 * j, hd, P.in[I_SR] + so, out + O_RSS + so); }
                } }
            } else if (k == 3) {
                if (PHON(7)) { MKCTX(); for (int u = C.vcu; u < 512; u += C.G) {
                    const int hd = u & 3, t = (u >> 2) & 63, b = u >> 8; r3_one(C, U, MIX, SST + ((size_t)((b * NTILE_B + t) * 4 + hd) << 14), b * SEQ + 256 * t, hd, P.pad);
                }
                if (P.pad & 8) phase_fz<KS2>(C, XB, XG, (const float*)(ws + WS_Y2), SSA, modl, 2 * DM, (const float*)(ws + WS_GS) + (size_t)(2 * l + 1) * NBT * DM); }
            }
        }
#if MK_LAUNCHES
        if (ph + 1 < P.ph_hi) { MKCTX(); xcd_barrier(bar, C.tid); }
#endif
    }
}

extern "C" void kernel_launch(void* const* d_in, const int* in_sizes, int n_in, void* d_out, int out_size, void* d_ws, size_t ws_size, hipStream_t stream) {
    static int grid = 0;
    if (grid == 0) {
        if (n_in != 18 || in_sizes[0] != MP * DM || (size_t)out_size != O_END || ws_size < WS_END) {
            fprintf(stderr, "kernel_launch: unexpected shapes (n_in %d, in0 %d, out %d, ws %zu need %zu)\n", n_in, n_in > 0 ? in_sizes[0] : -1, out_size, ws_size, (size_t)WS_END); grid = -1; return; }
        int dev = 0, cus = 0, per_cu = 0;
        if (hipGetDevice(&dev) != hipSuccess || hipDeviceGetAttribute(&cus, hipDeviceAttributeMultiprocessorCount, dev) != hipSuccess) { grid = -1; return; }
        if (hipFuncSetAttribute((const void*)fwd_kernel, hipFuncAttributeMaxDynamicSharedMemorySize, LDS_BYTES) != hipSuccess) { fprintf(stderr, "kernel_launch: hipFuncSetAttribute failed\n"); grid = -1; return; }
        if (hipOccupancyMaxActiveBlocksPerMultiprocessor(&per_cu, (const void*)fwd_kernel, 512, LDS_BYTES) != hipSuccess || per_cu < 1) { fprintf(stderr, "kernel_launch: occupancy query gave %d\n", per_cu); (void)hipGetLastError(); per_cu = 1; }
        grid = cus;
    }
    if (grid < 0) return;
    Params p{};
#if MK_LAUNCHES
    if (hipMemsetAsync((char*)d_ws + WS_CTL, 0, CTL_ZERO_BYTES, stream) != hipSuccess) { fprintf(stderr, "kernel_launch: memset of the barrier words failed\n"); return; }
#endif
    for (int i = 0; i < 18; ++i) p.in[i] = (const float*)d_in[i];
    p.out = (float*)d_out; p.ws = (unsigned char*)d_ws; p.pad = 15;
#if MK_LAUNCHES
    p.ph_lo = 0; p.ph_hi = NPHASE; p.coop = 1;
    void* args[] = {&p};
    hipError_t e = hipLaunchCooperativeKernel((const void*)fwd_kernel, dim3(grid), dim3(512), args, LDS_BYTES, stream);
    if (e != hipSuccess) fprintf(stderr, "kernel_launch: cooperative launch failed: %s (grid %d)\n", hipGetErrorString(e), grid);
#else
    for (int ph = 0; ph < NPHASE; ++ph) { p.ph_lo = ph; p.ph_hi = ph + 1; p.coop = 0;
#if defined(DUPK)
        { const int kk = ph == 0 ? -1 : (ph == 1 ? -2 : (ph == NPHASE - 1 ? 99 : (ph - 2) % 7));
          if (kk == DUPK) { p.pad = DUPU; hipLaunchKernelGGL(fwd_kernel, dim3(grid), dim3(512), LDS_BYTES, stream, p); } }
#endif
        p.pad = 15; hipLaunchKernelGGL(fwd_kernel, dim3(grid), dim3(512), LDS_BYTES, stream, p);
    }
#endif
}
```
